# Optimizing an MI355X kernel written in HIP

```python
import math
import jax, jax.numpy as jnp
from jax import lax
import numpy as np

D_MODEL = 2048
BATCH = 4
SEQ = 2048
DEPTH = 1

HEAD_DIM = 128
FOX_HEADS = 8
FOX_WIDTH = FOX_HEADS * HEAD_DIM
NSA_HEADS = 8
NSA_KV_GROUPS = 2
NSA_HPG = NSA_HEADS // NSA_KV_GROUPS
NSA_WIDTH = NSA_HEADS * HEAD_DIM
NSA_KV_WIDTH = NSA_KV_GROUPS * HEAD_DIM
N_NSA_BRANCHES = 3
CMP_LEN = 32
CMP_STRIDE = 16
CMP_HIDDEN = 256
SEL_LEN = 64
SEL_TOPK = 8
WINDOW = 512
REL_BUCKETS = 32
REL_MAX_DIST = 128
Q_BLOCK = 128
DEEPNORM_ALPHA = (2 * DEPTH) ** 0.25
DEEPNORM_BETA = (8 * DEPTH) ** -0.25
LN_EPS = 1e-5
NEG = -1e30

COL_LAYOUT = (
    ("fox_q", FOX_WIDTH, 1.0),
    ("fox_k", FOX_WIDTH, 1.0),
    ("fox_v", FOX_WIDTH, DEEPNORM_BETA),
    ("fox_f", FOX_HEADS, 1.0),
    ("fox_z", FOX_WIDTH, 1.0),
    ("nsa_q", NSA_WIDTH, 1.0),
    ("nsa_k_cmp", NSA_KV_WIDTH, 1.0),
    ("nsa_v_cmp", NSA_KV_WIDTH, DEEPNORM_BETA),
    ("nsa_k_sel", NSA_KV_WIDTH, 1.0),
    ("nsa_v_sel", NSA_KV_WIDTH, DEEPNORM_BETA),
    ("nsa_k_win", NSA_KV_WIDTH, 1.0),
    ("nsa_v_win", NSA_KV_WIDTH, DEEPNORM_BETA),
    ("nsa_gate", NSA_HEADS * N_NSA_BRANCHES, 1.0),
    ("nsa_z", NSA_WIDTH, 1.0),
    ("merge_a", D_MODEL, 1.0),
    ("merge_b", D_MODEL, 1.0),
)
IN_COLS = sum(c[1] for c in COL_LAYOUT)

kernel_name = "fox_nsa_gated_hybrid_deepnorm"


def layer_norm(z, g, b):
    zf = z.astype(jnp.float32)
    mu = jnp.mean(zf, axis=-1, keepdims=True)
    var = jnp.mean(jnp.square(zf - mu), axis=-1, keepdims=True)
    return ((zf - mu) * lax.rsqrt(var + LN_EPS) * g + b).astype(z.dtype)


def rel_bucket(dist):
    n = jnp.maximum(dist, 0)
    exact = REL_BUCKETS // 2
    large = exact + (jnp.log(jnp.maximum(n, 1).astype(jnp.float32) / exact)
                     / math.log(REL_MAX_DIST / exact) * (REL_BUCKETS - exact)).astype(jnp.int32)
    return jnp.where(n < exact, n, jnp.minimum(large, REL_BUCKETS - 1))


def fox_attention(q, k, v, log_f):
    B, S, H, dh = q.shape
    nq = S // Q_BLOCK
    c = jnp.cumsum(log_f, axis=1).transpose(0, 2, 1)
    qb = q.reshape(B, nq, Q_BLOCK, H, dh).transpose(1, 0, 2, 3, 4)
    cb = c.reshape(B, H, nq, Q_BLOCK).transpose(2, 0, 1, 3)
    s_pos = jnp.arange(S)
    scale = dh ** -0.5

    def block(args):
        qc, cc, q0 = args
        t_pos = q0 + jnp.arange(Q_BLOCK)
        s = jnp.einsum('bqhd,bshd->bhqs', qc, k).astype(jnp.float32) * scale
        s = s + cc[..., None] - c[:, :, None, :]
        s = jnp.where(s_pos[None, :] <= t_pos[:, None], s, NEG)
        p = jax.nn.softmax(s, axis=-1).astype(v.dtype)
        return jnp.einsum('bhqs,bshd->bqhd', p, v)

    o = lax.map(block, (qb, cb, jnp.arange(nq) * Q_BLOCK))
    return o.transpose(1, 0, 2, 3, 4).reshape(B, S, H, dh)


def nsa_attention(q, kc_raw, vc_raw, ks, vs, kw, vw, gates,
                  cmp_pos_k, cmp_pos_v, cmp_wk1, cmp_wk2, cmp_wv1, cmp_wv2, rel_bias):
    B, S, H, dh = q.shape
    G, HPG = NSA_KV_GROUPS, NSA_HPG
    scale = dh ** -0.5
    qg = q.reshape(B, S, G, HPG, dh)
    t_pos = jnp.arange(S)

    n_cmp = (S - CMP_LEN) // CMP_STRIDE + 1
    cmp_start = jnp.arange(n_cmp) * CMP_STRIDE
    blk_idx = cmp_start[:, None] + jnp.arange(CMP_LEN)[None, :]

    def compress(raw, pos, w1, w2):
        blocks = raw[:, blk_idx] + pos[None, None, :, None, :]
        flat = blocks.transpose(0, 1, 3, 2, 4).reshape(B, n_cmp, G, CMP_LEN * dh)
        return jax.nn.gelu(flat @ w1) @ w2

    k_cmp = compress(kc_raw, cmp_pos_k, cmp_wk1, cmp_wk2)
    v_cmp = compress(vc_raw, cmp_pos_v, cmp_wv1, cmp_wv2)
    blk_end = cmp_start + CMP_LEN - 1
    cmask = blk_end[None, :] <= t_pos[:, None]
    cbias = rel_bias[rel_bucket(t_pos[:, None] - blk_end[None, :])]
    cbias = cbias.transpose(2, 0, 1).reshape(G, HPG, S, n_cmp)
    sc = jnp.einsum('btghd,bcgd->bghtc', qg, k_cmp).astype(jnp.float32) * scale + cbias
    sc = jnp.where(cmask, sc, NEG)
    p_cmp = jax.nn.softmax(sc, axis=-1) * cmask
    o_cmp = jnp.einsum('bghtc,bcgd->btghd', p_cmp.astype(v_cmp.dtype), v_cmp).reshape(B, S, H, dh)

    n_sel = S // SEL_LEN
    sel_start = jnp.arange(n_sel) * SEL_LEN
    overlap = ((cmp_start[:, None] < sel_start[None, :] + SEL_LEN)
               & (cmp_start[:, None] + CMP_LEN > sel_start[None, :])).astype(jnp.float32)
    imp = jnp.einsum('bgtc,cj->bgtj', jnp.sum(p_cmp, axis=2), overlap)
    cur = t_pos // SEL_LEN
    j = jnp.arange(n_sel)
    forced = (j[None, :] == 0) | (j[None, :] == cur[:, None]) | (j[None, :] == cur[:, None] - 1)
    valid = sel_start[None, :] <= t_pos[:, None]
    imp = jnp.where(valid, jnp.where(forced, -NEG, imp), NEG)
    k_top = min(SEL_TOPK, n_sel)
    _, sel_idx = lax.top_k(imp, k_top)

    nq = S // Q_BLOCK
    qb = qg.reshape(B, nq, Q_BLOCK, G, HPG, dh).transpose(1, 0, 2, 3, 4, 5)
    ib = sel_idx.reshape(B, G, nq, Q_BLOCK, k_top).transpose(2, 0, 1, 3, 4)
    ks_blk = ks.reshape(B, n_sel, SEL_LEN, G, dh).transpose(0, 3, 1, 2, 4)
    vs_blk = vs.reshape(B, n_sel, SEL_LEN, G, dh).transpose(0, 3, 1, 2, 4)
    kw_pad = jnp.pad(kw, ((0, 0), (WINDOW, 0), (0, 0), (0, 0)))
    vw_pad = jnp.pad(vw, ((0, 0), (WINDOW, 0), (0, 0), (0, 0)))
    win_len = WINDOW + Q_BLOCK
    qi = jnp.arange(Q_BLOCK)
    kj = jnp.arange(win_len)
    wdist = WINDOW + qi[:, None] - kj[None, :]
    wband = (wdist >= 0) & (wdist < WINDOW)
    wbias = rel_bias[rel_bucket(wdist)].transpose(2, 0, 1).reshape(G, HPG, Q_BLOCK, win_len)
    tbl = rel_bias.T.reshape(G, HPG, REL_BUCKETS)
    gather_blocks = jax.vmap(jax.vmap(lambda blk, idx: blk[idx]))
    group_bias = jax.vmap(jax.vmap(lambda tg, bk: tg[:, bk]), in_axes=(None, 0))

    def block(args):
        qc, ic, q0 = args
        t = q0 + qi
        kg = gather_blocks(ks_blk, ic)
        vg = gather_blocks(vs_blk, ic)
        spos = ic[..., None] * SEL_LEN + jnp.arange(SEL_LEN)
        sdist = t[None, None, :, None, None] - spos
        ss = (jnp.einsum('bqghd,bgqkld->bghqkl', qc, kg).astype(jnp.float32) * scale
              + group_bias(tbl, rel_bucket(sdist)))
        ss = jnp.where((sdist >= 0)[:, :, None], ss, NEG)
        ps = jax.nn.softmax(ss.reshape(ss.shape[:4] + (-1,)), axis=-1).reshape(ss.shape).astype(vg.dtype)
        o_s = jnp.einsum('bghqkl,bgqkld->bqghd', ps, vg)
        kwc = lax.dynamic_slice_in_dim(kw_pad, q0, win_len, axis=1)
        vwc = lax.dynamic_slice_in_dim(vw_pad, q0, win_len, axis=1)
        sw = jnp.einsum('bqghd,bsgd->bghqs', qc, kwc).astype(jnp.float32) * scale + wbias
        wmask = wband & (q0 - WINDOW + kj >= 0)[None, :]
        sw = jnp.where(wmask, sw, NEG)
        pw = jax.nn.softmax(sw, axis=-1).astype(vwc.dtype)
        o_w = jnp.einsum('bghqs,bsgd->bqghd', pw, vwc)
        return o_s, o_w

    o_sel, o_win = lax.map(block, (qb, ib, jnp.arange(nq) * Q_BLOCK))
    o_sel = o_sel.transpose(1, 0, 2, 3, 4, 5).reshape(B, S, H, dh)
    o_win = o_win.transpose(1, 0, 2, 3, 4, 5).reshape(B, S, H, dh)
    return gates[..., 0:1] * o_cmp + gates[..., 1:2] * o_sel + gates[..., 2:3] * o_win


def hybrid_layer(x, w_in, b_f, cmp_pos_k, cmp_pos_v, cmp_wk1, cmp_wk2, cmp_wv1, cmp_wv2,
                 w_a, w_b, w_o, ln_g, ln_b, rel_bias):
    B, S, _ = x.shape
    h = x @ w_in
    offsets = list(np.cumsum([c[1] for c in COL_LAYOUT])[:-1])
    (fq, fk, fv, ff, fz, nq, nkc, nvc, nks, nvs, nkw, nvw, ng, nz, ga, gb) = jnp.split(h, offsets, axis=-1)
    heads_a = lambda t: t.reshape(B, S, FOX_HEADS, HEAD_DIM)
    kv_b = lambda t: t.reshape(B, S, NSA_KV_GROUPS, HEAD_DIM)

    log_f = jax.nn.log_sigmoid((ff + b_f).astype(jnp.float32))
    o_a = fox_attention(heads_a(fq), heads_a(fk), heads_a(fv), log_f).reshape(B, S, FOX_WIDTH)
    y_a = (o_a * jax.nn.silu(fz)) @ w_a

    gates = jax.nn.sigmoid(ng.reshape(B, S, NSA_HEADS, N_NSA_BRANCHES))
    o_b = nsa_attention(nq.reshape(B, S, NSA_HEADS, HEAD_DIM), kv_b(nkc), kv_b(nvc), kv_b(nks), kv_b(nvs),
                        kv_b(nkw), kv_b(nvw), gates, cmp_pos_k, cmp_pos_v, cmp_wk1, cmp_wk2,
                        cmp_wv1, cmp_wv2, rel_bias).reshape(B, S, NSA_WIDTH)
    y_b = (o_b * jax.nn.silu(nz)) @ w_b

    merged = jax.nn.sigmoid(ga) * y_a + jax.nn.sigmoid(gb) * y_b
    return layer_norm(DEEPNORM_ALPHA * x + merged @ w_o, ln_g, ln_b)


def setup_inputs(seed: int = 0) -> dict:
    key = jax.random.key(seed)
    ks = jax.random.split(key, 16)
    f32 = jnp.float32
    col_scale = jnp.concatenate([jnp.full((c[1],), c[2], f32) for c in COL_LAYOUT])
    kdim = CMP_LEN * HEAD_DIM
    return {
        "x": jax.random.normal(ks[0], (BATCH, SEQ, D_MODEL), f32),
        "w_in": jax.random.normal(ks[1], (DEPTH, D_MODEL, IN_COLS), f32) * D_MODEL ** -0.5 * col_scale,
        "b_f": 3.0 + 0.1 * jax.random.normal(ks[2], (DEPTH, FOX_HEADS), f32),
        "cmp_pos_k": 0.1 * jax.random.normal(ks[3], (DEPTH, CMP_LEN, HEAD_DIM), f32),
        "cmp_pos_v": 0.1 * jax.random.normal(ks[4], (DEPTH, CMP_LEN, HEAD_DIM), f32),
        "cmp_wk1": jax.random.normal(ks[5], (DEPTH, kdim, CMP_HIDDEN), f32) * kdim ** -0.5,
        "cmp_wk2": jax.random.normal(ks[6], (DEPTH, CMP_HIDDEN, HEAD_DIM), f32) * CMP_HIDDEN ** -0.5,
        "cmp_wv1": jax.random.normal(ks[7], (DEPTH, kdim, CMP_HIDDEN), f32) * kdim ** -0.5,
        "cmp_wv2": jax.random.normal(ks[8], (DEPTH, CMP_HIDDEN, HEAD_DIM), f32) * CMP_HIDDEN ** -0.5,
        "w_a": jax.random.normal(ks[9], (DEPTH, FOX_WIDTH, D_MODEL), f32) * FOX_WIDTH ** -0.5 * DEEPNORM_BETA,
        "w_b": jax.random.normal(ks[10], (DEPTH, NSA_WIDTH, D_MODEL), f32) * NSA_WIDTH ** -0.5 * DEEPNORM_BETA,
        "w_o": jax.random.normal(ks[11], (DEPTH, D_MODEL, D_MODEL), f32) * D_MODEL ** -0.5 * DEEPNORM_BETA,
        "ln_g": 1.0 + 0.02 * jax.random.normal(ks[12], (DEPTH, D_MODEL), f32),
        "ln_b": 0.02 * jax.random.normal(ks[13], (DEPTH, D_MODEL), f32),
        "rel_bias": 0.5 * jax.random.normal(ks[14], (REL_BUCKETS, NSA_HEADS), f32),
    }


def reference(x, w_in, b_f, cmp_pos_k, cmp_pos_v, cmp_wk1, cmp_wk2, cmp_wv1, cmp_wv2,
              w_a, w_b, w_o, ln_g, ln_b, rel_bias):
    for layer in range(DEPTH):
        x = hybrid_layer(x, w_in[layer], b_f[layer], cmp_pos_k[layer], cmp_pos_v[layer],
                         cmp_wk1[layer], cmp_wk2[layer], cmp_wv1[layer], cmp_wv2[layer],
                         w_a[layer], w_b[layer], w_o[layer], ln_g[layer], ln_b[layer], rel_bias)
    return x
```

```cpp
#include <hip/hip_runtime.h>
#include <cstdio>
#include <cstdint>

namespace {
constexpr int B_ = 4, S_ = 2048, D_ = 2048, M_ = B_ * S_;
constexpr int INC = 11808;
constexpr int C_FQ = 0, C_FK = 1024, C_FV = 2048, C_FF = 3072, C_FZ = 3080, C_NQ = 4104, C_KC = 5128, C_VC = 5384,
              C_KS = 5640, C_VS = 5896, C_KW = 6152, C_VW = 6408, C_NG = 6664, C_NZ = 6688, C_GA = 7712, C_GB = 9760;
constexpr int HMC = 7712;
constexpr int NCMP = 127;
constexpr float SCALE = 0.08838834764831845f;
constexpr float ALPHA = 1.189207115002721f;
constexpr size_t MiB = 1u << 20;
constexpr size_t WS_HM = 0, WS_PC = 256 * MiB, WS_OA = 288 * MiB, WS_OB = 320 * MiB, WS_CC = 352 * MiB, WS_KCMP = 353 * MiB,
                 WS_VCMP = 354 * MiB, WS_SEL = 355 * MiB, WS_END = 356 * MiB;

__device__ __forceinline__ int rel_bucket(int n) {
    if (n < 16) return n < 0 ? 0 : n;
    int b = 16;
    b += n >= 19; b += n >= 21; b += n >= 24; b += n >= 27; b += n >= 31; b += n >= 35; b += n >= 40; b += n >= 46;
    b += n >= 52; b += n >= 59; b += n >= 67; b += n >= 77; b += n >= 87; b += n >= 99; b += n >= 113;
    return b;
}
__device__ __forceinline__ float sigmoidf_(float v) { return 1.f / (1.f + expf(-v)); }
__device__ __forceinline__ float siluf_(float v) { return v / (1.f + expf(-v)); }
__device__ __forceinline__ float log_sigmoidf_(float v) { return fminf(v, 0.f) - log1pf(expf(-fabsf(v))); }
__device__ __forceinline__ float gelu_tanh(float v) { return 0.5f * v * (1.f + tanhf(0.7978845608028654f * (v + 0.044715f * v * v * v))); }

struct EpiStore { float* C; int ldc; int pad; __device__ void operator()(int m, int n, float a) const { C[(size_t)m * ldc + n] = a; } };
struct EpiGateA { float* MG; __device__ void operator()(int m, int n, float a) const { float* p = MG + (size_t)m * 4096 + n; *p = sigmoidf_(*p) * a; } };
struct EpiGateB { float* MG; __device__ void operator()(int m, int n, float a) const { float* p = MG + (size_t)m * 4096 + n; *p = *p + sigmoidf_(p[2048]) * a; } };
struct EpiRes { const float* X; float* O; __device__ void operator()(int m, int n, float a) const { O[(size_t)m * D_ + n] = ALPHA * X[(size_t)m * D_ + n] + a; } };

template <class Epi>
__global__ void __launch_bounds__(256) gemm_f32(const float* __restrict__ A, const float* __restrict__ Bm, int lda, int ldb, int N, int K, Epi epi) {
    __shared__ float As[16][68];
    __shared__ float Bs[16][68];
    const int tid = threadIdx.x, tx = tid & 15, ty = tid >> 4;
    const int m0 = blockIdx.y * 64, n0 = blockIdx.x * 64;
    float acc[4][4];
#pragma unroll
    for (int i = 0; i < 4; ++i)
#pragma unroll
        for (int j = 0; j < 4; ++j) acc[i][j] = 0.f;
    const int ar = tid >> 2, ac = (tid & 3) * 4;
    const int br = tid >> 4, bc = (tid & 15) * 4;
    for (int k0 = 0; k0 < K; k0 += 16) {
        const float4 a = *(const float4*)(A + (size_t)(m0 + ar) * lda + k0 + ac);
        As[ac + 0][ar] = a.x; As[ac + 1][ar] = a.y; As[ac + 2][ar] = a.z; As[ac + 3][ar] = a.w;
        float4 b = make_float4(0.f, 0.f, 0.f, 0.f);
        if (n0 + bc < N) b = *(const float4*)(Bm + (size_t)(k0 + br) * ldb + n0 + bc);
        *(float4*)&Bs[br][bc] = b;
        __syncthreads();
#pragma unroll
        for (int kk = 0; kk < 16; ++kk) {
            const float4 av = *(const float4*)&As[kk][ty * 4];
            const float4 bv = *(const float4*)&Bs[kk][tx * 4];
            const float aa[4] = {av.x, av.y, av.z, av.w}, bb[4] = {bv.x, bv.y, bv.z, bv.w};
#pragma unroll
            for (int i = 0; i < 4; ++i)
#pragma unroll
                for (int j = 0; j < 4; ++j) acc[i][j] += aa[i] * bb[j];
        }
        __syncthreads();
    }
#pragma unroll
    for (int i = 0; i < 4; ++i)
#pragma unroll
        for (int j = 0; j < 4; ++j) {
            const int n = n0 + tx * 4 + j;
            if (n < N) epi(m0 + ty * 4 + i, n, acc[i][j]);
        }
}

__global__ void fox_cumsum(const float* __restrict__ HM, const float* __restrict__ b_f, float* __restrict__ cc) {
    const int i = blockIdx.x * blockDim.x + threadIdx.x;
    if (i >= B_ * 8) return;
    const int b = i >> 3, h = i & 7;
    const float bf = b_f[h];
    double run = 0.0;
    for (int t = 0; t < S_; ++t) {
        const float v = HM[(size_t)(b * S_ + t) * HMC + C_FF + h] + bf;
        run += (double)log_sigmoidf_(v);
        cc[(size_t)i * S_ + t] = (float)run;
    }
}

__global__ void __launch_bounds__(256) compress_naive(const float* __restrict__ HM, const float* __restrict__ pos,
                                                      const float* __restrict__ w1, const float* __restrict__ w2, float* __restrict__ out, int col, int pad0) {
    __shared__ float flat[4096];
    __shared__ float hid[256];
    const int r = blockIdx.x;
    const int g = r & 1, c = (r >> 1) % NCMP, b = (r >> 1) / NCMP;
    const int tid = threadIdx.x;
    for (int i = tid; i < 4096; i += 256) {
        const int l = i >> 7, d = i & 127;
        flat[i] = HM[(size_t)(b * S_ + 16 * c + l) * HMC + col + g * 128 + d] + pos[l * 128 + d];
    }
    __syncthreads();
    float a = 0.f;
    for (int k = 0; k < 4096; ++k) a += flat[k] * w1[(size_t)k * 256 + tid];
    hid[tid] = gelu_tanh(a);
    __syncthreads();
    if (tid < 128) {
        float o = 0.f;
        for (int n = 0; n < 256; ++n) o += hid[n] * w2[n * 128 + tid];
        out[(size_t)r * 128 + tid] = o;
    }
}

template <int MODE>
__global__ void __launch_bounds__(128) attn_naive(const float* __restrict__ HM, const float* __restrict__ cc, const float* __restrict__ kcmp,
                                                  const float* __restrict__ vcmp, const float* __restrict__ rel_bias, const unsigned* __restrict__ selm,
                                                  float* __restrict__ pc, float* __restrict__ obuf) {
    __shared__ float qs[128];
    __shared__ float sc[2048];
    __shared__ float red[128];
    const int t = blockIdx.x, head = blockIdx.y, b = blockIdx.z, tid = threadIdx.x;
    const int g = head >> 2;
    const size_t row = (size_t)(b * S_ + t);
    const int qcol = (MODE == 0 ? C_FQ : C_NQ) + head * 128;
    qs[tid] = HM[row * HMC + qcol + tid];
    __syncthreads();
    int lo = 0, n = 0;
    if (MODE == 0 || MODE == 2) { lo = 0; n = t + 1; }
    if (MODE == 1) { lo = 0; n = t >= 31 ? (t - 31) / 16 + 1 : 0; if (n > NCMP) n = NCMP; }
    if (MODE == 3) { lo = t - 511 < 0 ? 0 : t - 511; n = t - lo + 1; }
    unsigned smask = 0;
    if (MODE == 2) smask = selm[(size_t)(b * 2 + g) * S_ + t];
    const float ct = MODE == 0 ? cc[(size_t)(b * 8 + head) * S_ + t] : 0.f;
    float mx = -INFINITY;
    for (int i = tid; i < n; i += 128) {
        const int j = lo + i;
        const float* kp;
        if (MODE == 0) kp = HM + (size_t)(b * S_ + j) * HMC + C_FK + head * 128;
        else if (MODE == 1) kp = kcmp + (size_t)((b * NCMP + j) * 2 + g) * 128;
        else if (MODE == 2) kp = HM + (size_t)(b * S_ + j) * HMC + C_KS + g * 128;
        else kp = HM + (size_t)(b * S_ + j) * HMC + C_KW + g * 128;
        float dot = 0.f;
#pragma unroll 8
        for (int d = 0; d < 128; d += 4) { const float4 kv = *(const float4*)(kp + d); dot += qs[d] * kv.x + qs[d + 1] * kv.y + qs[d + 2] * kv.z + qs[d + 3] * kv.w; }
        float s = dot * SCALE;
        if (MODE == 0) s += ct - cc[(size_t)(b * 8 + head) * S_ + j];
        else if (MODE == 1) s += rel_bias[rel_bucket(t - (16 * j + 31)) * 8 + head];
        else s += rel_bias[rel_bucket(t - j) * 8 + head];
        if (MODE == 2 && !((smask >> (j >> 6)) & 1u)) s = -INFINITY;
        sc[i] = s;
        mx = fmaxf(mx, s);
    }
    red[tid] = mx;
    __syncthreads();
    for (int o = 64; o > 0; o >>= 1) { if (tid < o) red[tid] = fmaxf(red[tid], red[tid + o]); __syncthreads(); }
    mx = red[0];
    __syncthreads();
    float sum = 0.f;
    for (int i = tid; i < n; i += 128) { const float e = expf(sc[i] - mx); sc[i] = e; sum += e; }
    red[tid] = sum;
    __syncthreads();
    for (int o = 64; o > 0; o >>= 1) { if (tid < o) red[tid] += red[tid + o]; __syncthreads(); }
    sum = red[0];
    const float inv = n > 0 ? 1.f / sum : 0.f;
    if (MODE == 1) { pc[((size_t)(b * 8 + head) * S_ + t) * 128 + tid] = tid < n ? sc[tid] * inv : 0.f; }
    float o = 0.f;
    for (int i = 0; i < n; ++i) {
        const int j = lo + i;
        const float* vp;
        if (MODE == 0) vp = HM + (size_t)(b * S_ + j) * HMC + C_FV + head * 128;
        else if (MODE == 1) vp = vcmp + (size_t)((b * NCMP + j) * 2 + g) * 128;
        else if (MODE == 2) vp = HM + (size_t)(b * S_ + j) * HMC + C_VS + g * 128;
        else vp = HM + (size_t)(b * S_ + j) * HMC + C_VW + g * 128;
        o += sc[i] * vp[tid];
    }
    o *= inv;
    float* op = obuf + row * 1024 + head * 128 + tid;
    if (MODE == 0) *op = o;
    else {
        const float gate = sigmoidf_(HM[row * HMC + C_NG + head * 3 + (MODE - 1)]);
        if (MODE == 1) *op = gate * o; else *op += gate * o;
    }
}

__global__ void topk_naive(const float* __restrict__ pc, unsigned* __restrict__ selm) {
    const int i = blockIdx.x * blockDim.x + threadIdx.x;
    if (i >= B_ * 2 * S_) return;
    const int t = i % S_, g = (i / S_) & 1, b = i / (2 * S_);
    const int cur = t >> 6;
    unsigned mask = 0;
    unsigned chosen = 0;
    int nch = 0;
    chosen |= 1u;
    chosen |= 1u << cur;
    if (cur >= 1) chosen |= 1u << (cur - 1);
    nch = __popc(chosen);
    if (cur + 1 <= 8) {
        mask = (cur + 1 >= 32) ? 0xffffffffu : ((1u << (cur + 1)) - 1u);
    } else {
        const float* p0 = pc + ((size_t)(b * 8 + g * 4) * S_ + t) * 128;
        for (int k = nch; k < 8; ++k) {
            float bv = -INFINITY; int bj = -1;
            for (int j = 1; j <= cur - 2; ++j) {
                if ((chosen >> j) & 1u) continue;
                float v = 0.f;
                for (int c = 4 * j - 1; c <= 4 * j + 3; ++c) {
                    if (c < 0 || c >= NCMP) continue;
                    float ps = 0.f;
                    for (int hp = 0; hp < 4; ++hp) ps += p0[(size_t)hp * S_ * 128 + c];
                    v += ps;
                }
                if (v > bv) { bv = v; bj = j; }
            }
            if (bj >= 0) chosen |= 1u << bj;
        }
        mask = chosen;
    }
    selm[i] = mask;
}

__global__ void mul_silu(float* __restrict__ O, const float* __restrict__ HM, int zcol, int pad0) {
    const size_t i = (size_t)blockIdx.x * blockDim.x + threadIdx.x;
    if (i >= (size_t)M_ * 1024) return;
    const size_t m = i >> 10; const int c = (int)(i & 1023);
    O[i] *= siluf_(HM[m * HMC + zcol + c]);
}

__global__ void __launch_bounds__(256) ln_rows(float* __restrict__ X, const float* __restrict__ g, const float* __restrict__ bta) {
    __shared__ float red[256];
    const int tid = threadIdx.x; float* xr = X + (size_t)blockIdx.x * D_;
    float v[8]; float s = 0.f;
#pragma unroll
    for (int i = 0; i < 8; ++i) { v[i] = xr[tid + 256 * i]; s += v[i]; }
    red[tid] = s; __syncthreads();
    for (int o = 128; o > 0; o >>= 1) { if (tid < o) red[tid] += red[tid + o]; __syncthreads(); }
    const float mean = red[0] * (1.f / D_); __syncthreads();
    float q = 0.f;
#pragma unroll
    for (int i = 0; i < 8; ++i) { v[i] -= mean; q += v[i] * v[i]; }
    red[tid] = q; __syncthreads();
    for (int o = 128; o > 0; o >>= 1) { if (tid < o) red[tid] += red[tid + o]; __syncthreads(); }
    const float rstd = rsqrtf(red[0] * (1.f / D_) + 1e-5f);
#pragma unroll
    for (int i = 0; i < 8; ++i) xr[tid + 256 * i] = v[i] * rstd * g[tid + 256 * i] + bta[tid + 256 * i];
}
}

extern "C" void kernel_launch(void* const* d_in, const int* in_sizes, int n_in, void* d_out, int out_size, void* d_ws, size_t ws_size, hipStream_t stream) {
    if (n_in != 15 || ws_size < WS_END || out_size != M_ * D_) { fprintf(stderr, "kernel_launch: unexpected shapes/ws (%d inputs, ws %zu, out %d)\n", n_in, ws_size, out_size); return; }
    const float* x = (const float*)d_in[0]; const float* w_in = (const float*)d_in[1]; const float* b_f = (const float*)d_in[2];
    const float* pos_k = (const float*)d_in[3]; const float* pos_v = (const float*)d_in[4];
    const float* wk1 = (const float*)d_in[5]; const float* wk2 = (const float*)d_in[6]; const float* wv1 = (const float*)d_in[7]; const float* wv2 = (const float*)d_in[8];
    const float* w_a = (const float*)d_in[9]; const float* w_b = (const float*)d_in[10]; const float* w_o = (const float*)d_in[11];
    const float* ln_g = (const float*)d_in[12]; const float* ln_b = (const float*)d_in[13]; const float* rel_bias = (const float*)d_in[14];
    char* ws = (char*)d_ws; float* out = (float*)d_out;
    float* HM = (float*)(ws + WS_HM); float* PC = (float*)(ws + WS_PC); float* OA = (float*)(ws + WS_OA); float* OB = (float*)(ws + WS_OB);
    float* CC = (float*)(ws + WS_CC); float* KC = (float*)(ws + WS_KCMP); float* VC = (float*)(ws + WS_VCMP); unsigned* SEL = (unsigned*)(ws + WS_SEL);
    float* MG = HM;

    gemm_f32<EpiStore><<<dim3((HMC + 63) / 64, M_ / 64), 256, 0, stream>>>(x, w_in, D_, INC, HMC, D_, EpiStore{HM, HMC, 0});
    fox_cumsum<<<1, 64, 0, stream>>>(HM, b_f, CC);
    compress_naive<<<B_ * NCMP * 2, 256, 0, stream>>>(HM, pos_k, wk1, wk2, KC, C_KC, 0);
    compress_naive<<<B_ * NCMP * 2, 256, 0, stream>>>(HM, pos_v, wv1, wv2, VC, C_VC, 0);
    attn_naive<0><<<dim3(S_, 8, B_), 128, 0, stream>>>(HM, CC, KC, VC, rel_bias, SEL, PC, OA);
    attn_naive<1><<<dim3(S_, 8, B_), 128, 0, stream>>>(HM, CC, KC, VC, rel_bias, SEL, PC, OB);
    topk_naive<<<(B_ * 2 * S_ + 255) / 256, 256, 0, stream>>>(PC, SEL);
    attn_naive<2><<<dim3(S_, 8, B_), 128, 0, stream>>>(HM, CC, KC, VC, rel_bias, SEL, PC, OB);
    attn_naive<3><<<dim3(S_, 8, B_), 128, 0, stream>>>(HM, CC, KC, VC, rel_bias, SEL, PC, OB);
    mul_silu<<<(M_ * 1024) / 256, 256, 0, stream>>>(OA, HM, C_FZ, 0);
    mul_silu<<<(M_ * 1024) / 256, 256, 0, stream>>>(OB, HM, C_NZ, 0);
    gemm_f32<EpiStore><<<dim3(4096 / 64, M_ / 64), 256, 0, stream>>>(x, w_in + C_GA, D_, INC, 4096, D_, EpiStore{MG, 4096, 0});
    gemm_f32<EpiGateA><<<dim3(2048 / 64, M_ / 64), 256, 0, stream>>>(OA, w_a, 1024, D_, 2048, 1024, EpiGateA{MG});
    gemm_f32<EpiGateB><<<dim3(2048 / 64, M_ / 64), 256, 0, stream>>>(OB, w_b, 1024, D_, 2048, 1024, EpiGateB{MG});
    gemm_f32<EpiRes><<<dim3(2048 / 64, M_ / 64), 256, 0, stream>>>(MG, w_o, 4096, D_, 2048, 2048, EpiRes{x, out});
    ln_rows<<<M_, 256, 0, stream>>>(out, ln_g, ln_b);
}
```

```cpp
#include <hip/hip_runtime.h>
#include <hip/hip_cooperative_groups.h>
#include <cstdio>
#include <cstdint>
namespace cg = cooperative_groups;

namespace {
constexpr int B_ = 4, S_ = 2048, D_ = 2048, M_ = B_ * S_;
constexpr int INC = 11808;
constexpr int NCMP = 127;
constexpr float SCALE = 0.08838834764831845f;
constexpr float ALPHA = 1.189207115002721f;
constexpr int PITCH = 11776;
constexpr int H_FQ = 0, H_FK = 1024, H_FV = 2048, H_FZ = 3072, H_NQ = 4096, H_KC = 5120, H_VC = 5376, H_KS = 5632, H_VS = 5888,
              H_KW = 6144, H_VW = 6400, H_NZ = 6656, H_GA = 7680, H_GB = 9728;
constexpr size_t MiB = 1u << 20;
constexpr size_t WS_CTL = 0;
constexpr size_t WS_HB = 1 * MiB;
constexpr size_t WS_LOGF = 186 * MiB;
constexpr size_t WS_NGATE = 187 * MiB;
constexpr size_t WS_CC = 188 * MiB;
constexpr size_t WS_KCMP = 189 * MiB;
constexpr size_t WS_VCMP = 190 * MiB;
constexpr size_t WS_SEL = 191 * MiB;
constexpr size_t WS_OA = 192 * MiB;
constexpr size_t WS_OB = 208 * MiB;
constexpr size_t WS_MRG = 224 * MiB;
constexpr size_t WS_PC = 256 * MiB;
constexpr size_t WS_OAF = 288 * MiB;
constexpr size_t WS_OBF = 320 * MiB;
constexpr size_t WS_XB = 256 * MiB;
constexpr size_t WS_WINT = 288 * MiB;
constexpr size_t WS_T1B = 256 * MiB;
constexpr size_t WS_WABT = 352 * MiB;
constexpr size_t WS_WOT = 360 * MiB;
constexpr size_t WS_END = 368 * MiB;

constexpr int NTHREADS = 512;
constexpr int LDS_BYTES = 147456;

typedef unsigned short bf16_t;
__device__ __forceinline__ float bf2f(bf16_t v) { return __uint_as_float((unsigned)v << 16); }
__device__ __forceinline__ bf16_t f2bf(float f) { unsigned u = __float_as_uint(f); return (bf16_t)((u + 0x7fffu + ((u >> 16) & 1u)) >> 16); }

__device__ __forceinline__ int rel_bucket(int n) {
    if (n < 16) return n < 0 ? 0 : n;
    int b = 16;
    b += n >= 19; b += n >= 21; b += n >= 24; b += n >= 27; b += n >= 31; b += n >= 35; b += n >= 40; b += n >= 46;
    b += n >= 52; b += n >= 59; b += n >= 67; b += n >= 77; b += n >= 87; b += n >= 99; b += n >= 113;
    return b;
}
__device__ __forceinline__ float sigmoidf_(float v) { return 1.f / (1.f + expf(-v)); }
__device__ __forceinline__ float siluf_(float v) { return v / (1.f + expf(-v)); }
__device__ __forceinline__ float log_sigmoidf_(float v) { return fminf(v, 0.f) - log1pf(expf(-fabsf(v))); }
__device__ __forceinline__ float gelu_tanh(float v) { return 0.5f * v * (1.f + tanhf(0.7978845608028654f * (v + 0.044715f * v * v * v))); }

struct Params { const float* in[15]; float* out; unsigned char* ws; };

template <class TA> __device__ __forceinline__ float4 ld4(const TA* p);
template <> __device__ __forceinline__ float4 ld4<float>(const float* p) { return *(const float4*)p; }
template <> __device__ __forceinline__ float4 ld4<bf16_t>(const bf16_t* p) { const uint2 u = *(const uint2*)p; return make_float4(__uint_as_float(u.x << 16), __uint_as_float(u.x & 0xffff0000u), __uint_as_float(u.y << 16), __uint_as_float(u.y & 0xffff0000u)); }

template <class TA, class Epi>
__device__ __forceinline__ void gemm_naive_phase(const TA* __restrict__ A, const float* __restrict__ Bm, int lda, int ldb, int Mr, int N, int K, const Epi& epi, unsigned char* lds) {
    const int half = threadIdx.x >> 8, tid = threadIdx.x & 255, tx = tid & 15, ty = tid >> 4;
    float (*As)[68] = (float (*)[68])(lds + half * 8704);
    float (*Bs)[68] = (float (*)[68])(lds + half * 8704 + 4352);
    const int ntn = (N + 63) / 64, nvb = (Mr / 64) * ntn, stride = gridDim.x * 2;
    const int iters = (nvb + stride - 1) / stride;
    const int ar = tid >> 2, ac = (tid & 3) * 4, br = tid >> 4, bc = (tid & 15) * 4;
    for (int it = 0; it < iters; ++it) {
        const int vb = it * stride + blockIdx.x * 2 + half;
        const bool act = vb < nvb;
        const int m0 = act ? (vb / ntn) * 64 : 0, n0 = act ? (vb % ntn) * 64 : 0;
        float acc[4][4];
#pragma unroll
        for (int i = 0; i < 4; ++i)
#pragma unroll
            for (int j = 0; j < 4; ++j) acc[i][j] = 0.f;
        for (int k0 = 0; k0 < K; k0 += 16) {
            const float4 a = ld4<TA>(A + (size_t)(m0 + ar) * lda + k0 + ac);
            As[ac + 0][ar] = a.x; As[ac + 1][ar] = a.y; As[ac + 2][ar] = a.z; As[ac + 3][ar] = a.w;
            float4 b = make_float4(0.f, 0.f, 0.f, 0.f);
            if (n0 + bc < N) b = *(const float4*)(Bm + (size_t)(k0 + br) * ldb + n0 + bc);
            *(float4*)&Bs[br][bc] = b;
            __syncthreads();
#pragma unroll
            for (int kk = 0; kk < 16; ++kk) {
                const float4 av = *(const float4*)&As[kk][ty * 4];
                const float4 bv = *(const float4*)&Bs[kk][tx * 4];
                const float aa[4] = {av.x, av.y, av.z, av.w}, bb[4] = {bv.x, bv.y, bv.z, bv.w};
#pragma unroll
                for (int i = 0; i < 4; ++i)
#pragma unroll
                    for (int j = 0; j < 4; ++j) acc[i][j] += aa[i] * bb[j];
            }
            __syncthreads();
        }
        if (act) {
#pragma unroll
            for (int i = 0; i < 4; ++i)
#pragma unroll
                for (int j = 0; j < 4; ++j) { const int n = n0 + tx * 4 + j; if (n < N) epi(m0 + ty * 4 + i, n, acc[i][j]); }
        }
    }
}
struct EpiH {
    bf16_t* HB; float* LOGF; float* NGATE; const float* b_f;
    __device__ __forceinline__ void operator()(int m, int n, float a) const {
        if (n < 3072) HB[(size_t)m * PITCH + n] = f2bf(a);
        else if (n < 3080) LOGF[(size_t)m * 8 + (n - 3072)] = log_sigmoidf_(a + b_f[n - 3072]);
        else if (n < 4104) HB[(size_t)m * PITCH + n - 8] = f2bf(siluf_(a));
        else if (n < 6664) HB[(size_t)m * PITCH + n - 8] = f2bf(a);
        else if (n < 6688) NGATE[(size_t)m * 24 + (n - 6664)] = sigmoidf_(a);
        else if (n < 7712) HB[(size_t)m * PITCH + n - 32] = f2bf(siluf_(a));
        else HB[(size_t)m * PITCH + n - 32] = f2bf(sigmoidf_(a));
    }
};
struct EpiGateA { const bf16_t* HB; float* T1; __device__ __forceinline__ void operator()(int m, int n, float a) const { T1[(size_t)m * 2048 + n] = bf2f(HB[(size_t)m * PITCH + H_GA + n]) * a; } };
struct EpiGateB { const bf16_t* HB; const float* T1; bf16_t* MRG; __device__ __forceinline__ void operator()(int m, int n, float a) const { MRG[(size_t)m * 2048 + n] = f2bf(T1[(size_t)m * 2048 + n] + bf2f(HB[(size_t)m * PITCH + H_GB + n]) * a); } };
struct EpiRes { const float* X; float* O; __device__ __forceinline__ void operator()(int m, int n, float a) const { O[(size_t)m * D_ + n] = ALPHA * X[(size_t)m * D_ + n] + a; } };

__device__ __forceinline__ void cumsum_phase(const float* __restrict__ LOGF, float* __restrict__ CC) {
    const int lane = threadIdx.x & 63, gw = blockIdx.x * (NTHREADS / 64) + (threadIdx.x >> 6);
    if (gw >= B_ * 8) return;
    const int b = gw >> 3, h = gw & 7;
    double run = 0.0;
    for (int i = 0; i < 32; ++i) run += (double)LOGF[(size_t)(b * S_ + lane * 32 + i) * 8 + h];
    double incl = run;
#pragma unroll
    for (int o = 1; o < 64; o <<= 1) { const double v = __shfl_up(incl, o); if (lane >= o) incl += v; }
    double base = incl - run;
    for (int i = 0; i < 32; ++i) { base += (double)LOGF[(size_t)(b * S_ + lane * 32 + i) * 8 + h]; CC[(size_t)gw * S_ + lane * 32 + i] = (float)base; }
}

__device__ __forceinline__ void compress_naive_phase(const bf16_t* __restrict__ HB, const float* const* in, bf16_t* KCMP, bf16_t* VCMP, unsigned char* lds) {
    const int half = threadIdx.x >> 8, tid = threadIdx.x & 255;
    float* flat = (float*)(lds + half * 18432);
    float* hid = flat + 4096;
    const int nvb = 2 * B_ * 128 * 2, stride = gridDim.x * 2, iters = (nvb + stride - 1) / stride;
    for (int it = 0; it < iters; ++it) {
        const int vb = it * stride + blockIdx.x * 2 + half;
        const bool act = vb < nvb;
        const int kv = vb & 1, g = (vb >> 1) & 1, c = (vb >> 2) & 127, b = (vb >> 9) & 3;
        const float* pos = in[3 + kv]; const float* w1 = in[kv ? 7 : 5]; const float* w2 = in[kv ? 8 : 6];
        bf16_t* out = (kv ? VCMP : KCMP) + (size_t)((b * 2 + g) * 128 + c) * 128;
        const bool real = act && c < NCMP;
        if (real) for (int i = tid; i < 4096; i += 256) { const int l = i >> 7, d = i & 127;
            flat[i] = bf2f(HB[(size_t)(b * S_ + 16 * c + l) * PITCH + (kv ? H_VC : H_KC) + g * 128 + d]) + pos[l * 128 + d]; }
        __syncthreads();
        float a = 0.f;
        if (real) { for (int k = 0; k < 4096; ++k) a += flat[k] * w1[(size_t)k * 256 + tid]; hid[tid] = gelu_tanh(a); }
        __syncthreads();
        if (act && tid < 128) {
            float o = 0.f;
            if (real) for (int n = 0; n < 256; ++n) o += hid[n] * w2[n * 128 + tid];
            out[tid] = f2bf(o);
        }
        __syncthreads();
    }
}

template <int MODE>
__device__ __forceinline__ void attn_naive_phase(const bf16_t* __restrict__ HB, const float* __restrict__ CC, const bf16_t* __restrict__ KCMP, const bf16_t* __restrict__ VCMP,
                                                 const float* __restrict__ rel_bias, const float* __restrict__ NGATE, const unsigned* __restrict__ SEL, float* __restrict__ PC, float* __restrict__ obuf, unsigned char* lds) {
    const int sub = threadIdx.x >> 7, tid = threadIdx.x & 127;
    float* qs = (float*)(lds + sub * 9216);
    float* sc = qs + 128;
    float* red = sc + 2048;
    const int nvb = S_ * 8 * B_, stride = gridDim.x * 4, iters = (nvb + stride - 1) / stride;
    for (int it = 0; it < iters; ++it) {
        const int vb = it * stride + blockIdx.x * 4 + sub;
        const bool act = vb < nvb;
        const int t = vb & (S_ - 1), head = (vb >> 11) & 7, b = (vb >> 14) & 3, g = head >> 2;
        const size_t row = (size_t)(b * S_ + t);
        qs[tid] = bf2f(HB[row * PITCH + (MODE == 0 ? H_FQ : H_NQ) + head * 128 + tid]);
        __syncthreads();
        int lo = 0, n = 0;
        if (MODE == 0 || MODE == 2) { lo = 0; n = t + 1; }
        if (MODE == 1) { lo = 0; n = t >= 31 ? (t - 31) / 16 + 1 : 0; if (n > NCMP) n = NCMP; }
        if (MODE == 3) { lo = t - 511 < 0 ? 0 : t - 511; n = t - lo + 1; }
        if (!act) n = 0;
        unsigned smask = 0;
        if (MODE == 2) smask = SEL[(size_t)(b * 2 + g) * S_ + t];
        const float ct = MODE == 0 ? CC[(size_t)(b * 8 + head) * S_ + t] : 0.f;
        float mx = -INFINITY;
        for (int i = tid; i < n; i += 128) {
            const int j = lo + i;
            const bf16_t* kp;
            if (MODE == 0) kp = HB + (size_t)(b * S_ + j) * PITCH + H_FK + head * 128;
            else if (MODE == 1) kp = KCMP + (size_t)((b * 2 + g) * 128 + j) * 128;
            else if (MODE == 2) kp = HB + (size_t)(b * S_ + j) * PITCH + H_KS + g * 128;
            else kp = HB + (size_t)(b * S_ + j) * PITCH + H_KW + g * 128;
            float dot = 0.f;
#pragma unroll 8
            for (int d = 0; d < 128; d += 4) { const float4 kv = ld4<bf16_t>(kp + d); dot += qs[d] * kv.x + qs[d + 1] * kv.y + qs[d + 2] * kv.z + qs[d + 3] * kv.w; }
            float s = dot * SCALE;
            if (MODE == 0) s += ct - CC[(size_t)(b * 8 + head) * S_ + j];
            else if (MODE == 1) s += rel_bias[rel_bucket(t - (16 * j + 31)) * 8 + head];
            else s += rel_bias[rel_bucket(t - j) * 8 + head];
            if (MODE == 2 && !((smask >> (j >> 6)) & 1u)) s = -INFINITY;
            sc[i] = s;
            mx = fmaxf(mx, s);
        }
        red[tid] = mx;
        __syncthreads();
        for (int o = 64; o > 0; o >>= 1) { if (tid < o) red[tid] = fmaxf(red[tid], red[tid + o]); __syncthreads(); }
        mx = red[0];
        __syncthreads();
        float sum = 0.f;
        for (int i = tid; i < n; i += 128) { const float e = expf(sc[i] - mx); sc[i] = e; sum += e; }
        red[tid] = sum;
        __syncthreads();
        for (int o = 64; o > 0; o >>= 1) { if (tid < o) red[tid] += red[tid + o]; __syncthreads(); }
        sum = red[0];
        const float inv = n > 0 ? 1.f / sum : 0.f;
        if (MODE == 1 && act) PC[((size_t)(b * 8 + head) * S_ + t) * 128 + tid] = tid < n ? sc[tid] * inv : 0.f;
        float o = 0.f;
        for (int i = 0; i < n; ++i) {
            const int j = lo + i;
            const bf16_t* vp;
            if (MODE == 0) vp = HB + (size_t)(b * S_ + j) * PITCH + H_FV + head * 128;
            else if (MODE == 1) vp = VCMP + (size_t)((b * 2 + g) * 128 + j) * 128;
            else if (MODE == 2) vp = HB + (size_t)(b * S_ + j) * PITCH + H_VS + g * 128;
            else vp = HB + (size_t)(b * S_ + j) * PITCH + H_VW + g * 128;
            o += sc[i] * bf2f(vp[tid]);
        }
        o *= inv;
        if (act) {
            float* op = obuf + row * 1024 + head * 128 + tid;
            if (MODE == 0) *op = o;
            else { const float gate = NGATE[row * 24 + head * 3 + (MODE - 1)]; if (MODE == 1) *op = gate * o; else *op += gate * o; }
        }
        __syncthreads();
    }
}

__device__ __forceinline__ void topk_naive_phase(const float* __restrict__ PC, unsigned* __restrict__ SEL) {
    for (int i = blockIdx.x * NTHREADS + threadIdx.x; i < B_ * 2 * S_; i += gridDim.x * NTHREADS) {
        const int t = i % S_, g = (i / S_) & 1, b = i / (2 * S_);
        const int cur = t >> 6;
        unsigned chosen = 1u | (1u << cur);
        if (cur >= 1) chosen |= 1u << (cur - 1);
        unsigned mask;
        if (cur + 1 <= 8) mask = (1u << (cur + 1)) - 1u;
        else {
            for (int k = 3; k < 8; ++k) {
                float bv = -INFINITY; int bj = -1;
                for (int j = 1; j <= cur - 2; ++j) {
                    if ((chosen >> j) & 1u) continue;
                    float v = 0.f;
                    for (int c = 4 * j - 1; c <= 4 * j + 3; ++c) {
                        if (c < 0 || c >= NCMP) continue;
                        float ps = 0.f;
                        for (int hp = 0; hp < 4; ++hp) ps += PC[((size_t)(b * 8 + g * 4 + hp) * S_ + t) * 128 + c];
                        v += ps;
                    }
                    if (v > bv) { bv = v; bj = j; }
                }
                if (bj >= 0) chosen |= 1u << bj;
            }
            mask = chosen;
        }
        SEL[i] = mask;
    }
}

__device__ __forceinline__ void mulz_phase(const float* __restrict__ Of, const bf16_t* __restrict__ HB, int zcol, bf16_t* __restrict__ O) {
    for (size_t i = (size_t)blockIdx.x * NTHREADS + threadIdx.x; i < (size_t)M_ * 1024; i += (size_t)gridDim.x * NTHREADS) {
        const size_t m = i >> 10; const int c = (int)(i & 1023);
        O[i] = f2bf(Of[i] * bf2f(HB[m * PITCH + zcol + c]));
    }
}

__device__ __forceinline__ void ln_phase(float* __restrict__ X, const float* __restrict__ g, const float* __restrict__ bta, unsigned char* lds) {
    const int half = threadIdx.x >> 8, tid = threadIdx.x & 255;
    float* red = (float*)(lds + half * 1024);
    for (int r0 = blockIdx.x * 2; r0 < M_; r0 += gridDim.x * 2) {
        float* xr = X + (size_t)(r0 + half) * D_;
        float v[8]; float s = 0.f;
#pragma unroll
        for (int i = 0; i < 8; ++i) { v[i] = xr[tid + 256 * i]; s += v[i]; }
        red[tid] = s; __syncthreads();
        for (int o = 128; o > 0; o >>= 1) { if (tid < o) red[tid] += red[tid + o]; __syncthreads(); }
        const float mean = red[0] * (1.f / D_); __syncthreads();
        float q = 0.f;
#pragma unroll
        for (int i = 0; i < 8; ++i) { v[i] -= mean; q += v[i] * v[i]; }
        red[tid] = q; __syncthreads();
        for (int o = 128; o > 0; o >>= 1) { if (tid < o) red[tid] += red[tid + o]; __syncthreads(); }
        const float rstd = rsqrtf(red[0] * (1.f / D_) + 1e-5f);
        __syncthreads();
#pragma unroll
        for (int i = 0; i < 8; ++i) xr[tid + 256 * i] = v[i] * rstd * g[tid + 256 * i] + bta[tid + 256 * i];
    }
}


namespace pg8 {
#define PG8_LAS __attribute__((address_space(3)))
typedef unsigned short bf16_t;
typedef short bf16x8 __attribute__((ext_vector_type(8)));
typedef float f32x4 __attribute__((ext_vector_type(4)));
typedef unsigned u32x4 __attribute__((ext_vector_type(4)));
constexpr int BM = 256, BK = 64, HALF = 128, HTB = HALF * BK * 2  , STAGE_BYTES = 8 * HTB, NXCD = 8, WGM = 8;

__host__ __device__ __forceinline__ int lds_byte(int r, int c) { const int st = (r >> 4) * 2 + (c >> 5), rr = r & 15, cc = c & 31, ob = rr * 64 + cc * 2; return st * 1024 + (ob ^ (((ob >> 9) & 1) << 5)); }
__host__ __device__ __forceinline__ void stage_rc(int b, int& R, int& C) { const int st = b / 1024, sb = b % 1024, swz = sb ^ (((sb >> 9) & 1) << 5); R = (st >> 1) * 16 + swz / 64; C = (st & 1) * 32 + (swz % 64) / 2; }
__host__ __device__ __forceinline__ int perm32(int rho) { const int n = rho >> 4, i = rho & 15; return 8 * (i >> 2) + 4 * n + (i & 3); }

struct Unit { int pm, pn; };
struct Gemm { const bf16_t* A; const bf16_t* Bt; int M, N, K; };

struct StaticOrder {
    int nM, nN, nwg, G, c;
    __host__ __device__ void init(int M, int N, int G_, int c_) { nM = M / BM; nN = N / BM; nwg = nM * nN; G = G_; c = c_; }
    __host__ __device__ bool next(int i, Unit& u) const {
        const long L = (long)i * G + c; if (L >= nwg) return false;
        int wgid = (int)L; { const int q = nwg / NXCD, r = nwg % NXCD, xcd = wgid % NXCD, off = wgid / NXCD; wgid = (xcd < r ? xcd * (q + 1) : r * (q + 1) + (xcd - r) * q) + off; }
        const int nig = WGM * nN, gid = wgid / nig, fm = gid * WGM, gsz = (nM - fm) < WGM ? (nM - fm) : WGM;
        u.pm = fm + ((wgid % nig) % gsz); u.pn = (wgid % nig) / gsz; return true;
    }
    __device__ __forceinline__ void a_ready(const Unit&) const {}
    __device__ __forceinline__ void done(const Unit&) const {}
};

__device__ __forceinline__ unsigned cvt_pk_bf16(float lo, float hi) { unsigned r; asm volatile("v_cvt_pk_bf16_f32 %0, %1, %2" : "=v"(r) : "v"(lo), "v"(hi)); return r; }
__device__ __forceinline__ float fast_sigmoid(float v) { return __builtin_amdgcn_rcpf(1.f + __builtin_amdgcn_exp2f(-1.4426950408889634f * v)); }
__device__ __forceinline__ f32x4 act4(f32x4 v, int act) {
    if (act == 0) return v;
    f32x4 s; s[0] = fast_sigmoid(v[0]); s[1] = fast_sigmoid(v[1]); s[2] = fast_sigmoid(v[2]); s[3] = fast_sigmoid(v[3]);
    return act == 1 ? v * s : s;
}
struct EpiH1 {
    static constexpr bool PERM = true, AFTER_DRAIN = false;
    bf16_t* HB; float* LOGF; float* NGATE; const float* b_f;
    __device__ __forceinline__ void operator()(const f32x4 (&acc)[2][2][4][2], const Unit& u, int wr, int wc, int fr, int fq) const {
        const int row0 = u.pm * BM + wr * 64 + fr;
        if (u.pn < 46) {
            const int act = ((u.pn >= 12 && u.pn < 16) || (u.pn >= 26 && u.pn < 30)) ? 1 : (u.pn >= 30 ? 2 : 0);
            const int col0 = u.pn * BM + wc * 32 + 8 * fq;
#pragma unroll
            for (int ai = 0; ai < 2; ++ai)
#pragma unroll
                for (int m = 0; m < 4; ++m) { bf16_t* rowp = HB + (size_t)(row0 + ai * HALF + m * 16) * 11776 + col0;
#pragma unroll
                    for (int bj = 0; bj < 2; ++bj) { const f32x4 v0 = act4(acc[ai][bj][m][0], act), v1 = act4(acc[ai][bj][m][1], act);
                        u32x4 w; w.x = cvt_pk_bf16(v0[0], v0[1]); w.y = cvt_pk_bf16(v0[2], v0[3]); w.z = cvt_pk_bf16(v1[0], v1[1]); w.w = cvt_pk_bf16(v1[2], v1[3]);
                        *(u32x4*)(rowp + bj * HALF) = w; } }
        } else if (wc == 0) {
#pragma unroll
            for (int ai = 0; ai < 2; ++ai)
#pragma unroll
                for (int m = 0; m < 4; ++m) { const size_t row = (size_t)(row0 + ai * HALF + m * 16);
#pragma unroll
                    for (int n = 0; n < 2; ++n) { const f32x4 v = acc[ai][0][m][n];
                        if (fq == 0) { f32x4 o;
#pragma unroll
                            for (int e = 0; e < 4; ++e) { const float t = v[e] + b_f[4 * n + e]; o[e] = fminf(t, 0.f) - log1pf(expf(-fabsf(t))); }
                            *(f32x4*)(LOGF + row * 8 + 4 * n) = o; }
                        else { f32x4 o;
#pragma unroll
                            for (int e = 0; e < 4; ++e) o[e] = 1.f / (1.f + expf(-v[e]));
                            *(f32x4*)(NGATE + row * 24 + 8 * fq + 4 * n - 8) = o; } } }
        }
    }
};
struct EpiMerge {
    static constexpr bool PERM = true, AFTER_DRAIN = false;
    const bf16_t* HB; u32x4* T1; bf16_t* MRG;
    __device__ __forceinline__ void operator()(const f32x4 (&acc)[2][2][4][2], const Unit& u, int wr, int wc, int fr, int fq) const {
        const int pass = u.pm >> 5, pm = u.pm & 31, pn = u.pn & 7;
        const int row0 = pm * BM + wr * 64 + fr, col0 = pn * BM + wc * 32 + 8 * fq;
        u32x4* t1 = T1 + (size_t)(pm * 8 + pn) * (16 * 512) + threadIdx.x;
        const int gcol = (pass ? 9728 : 7680) + col0;
#pragma unroll
        for (int ai = 0; ai < 2; ++ai)
#pragma unroll
            for (int m = 0; m < 4; ++m) { const size_t row = (size_t)(row0 + ai * HALF + m * 16);
#pragma unroll
                for (int bj = 0; bj < 2; ++bj) {
                    const u32x4 gw = *(const u32x4*)(HB + row * 11776 + gcol + bj * HALF);
                    f32x4 g0, g1; g0[0] = __uint_as_float(gw.x << 16); g0[1] = __uint_as_float(gw.x & 0xffff0000u); g0[2] = __uint_as_float(gw.y << 16); g0[3] = __uint_as_float(gw.y & 0xffff0000u);
                    g1[0] = __uint_as_float(gw.z << 16); g1[1] = __uint_as_float(gw.z & 0xffff0000u); g1[2] = __uint_as_float(gw.w << 16); g1[3] = __uint_as_float(gw.w & 0xffff0000u);
                    f32x4 v0 = acc[ai][bj][m][0] * g0, v1 = acc[ai][bj][m][1] * g1;
                    u32x4* tp = t1 + (size_t)((ai * 4 + m) * 2 + bj) * 512;
                    if (pass) { const u32x4 tw = *tp;
                        v0[0] += __uint_as_float(tw.x << 16); v0[1] += __uint_as_float(tw.x & 0xffff0000u); v0[2] += __uint_as_float(tw.y << 16); v0[3] += __uint_as_float(tw.y & 0xffff0000u);
                        v1[0] += __uint_as_float(tw.z << 16); v1[1] += __uint_as_float(tw.z & 0xffff0000u); v1[2] += __uint_as_float(tw.w << 16); v1[3] += __uint_as_float(tw.w & 0xffff0000u); }
                    u32x4 w; w.x = cvt_pk_bf16(v0[0], v0[1]); w.y = cvt_pk_bf16(v0[2], v0[3]); w.z = cvt_pk_bf16(v1[0], v1[1]); w.w = cvt_pk_bf16(v1[2], v1[3]);
                    if (pass) *(u32x4*)(MRG + row * 2048 + col0 + bj * HALF) = w; else *tp = w; } }
    }
};
struct PairOrder {
    int G, c;
    __device__ __forceinline__ bool next(int i, Unit& u) const {
        StaticOrder s; s.init(8192, 2048, G, c);
        if (!s.next(i >> 1, u)) return false;
        const int pass = i & 1; u.pm += 32 * pass; u.pn += 8 * pass; return true;
    }
    __device__ __forceinline__ void a_ready(const Unit&) const {}
    __device__ __forceinline__ void done(const Unit&) const {}
};
struct EpiRes5 {
    static constexpr bool PERM = false, AFTER_DRAIN = false;
    const float* X; float* O;
    __device__ __forceinline__ void operator()(const f32x4 (&acc)[2][2][4][2], const Unit& u, int wr, int wc, int fr, int fq) const {
        const int row0 = u.pm * BM + wr * 64 + fr, col0 = u.pn * BM + wc * 32 + 4 * fq;
#pragma unroll
        for (int ai = 0; ai < 2; ++ai)
#pragma unroll
            for (int m = 0; m < 4; ++m) { const size_t off = (size_t)(row0 + ai * HALF + m * 16) * 2048 + col0;
#pragma unroll
                for (int bj = 0; bj < 2; ++bj)
#pragma unroll
                    for (int n = 0; n < 2; ++n) { const f32x4 xv = *(const f32x4*)(X + off + bj * HALF + n * 16);
                        *(f32x4*)(O + off + bj * HALF + n * 16) = xv * 1.189207115002721f + acc[ai][bj][m][n]; } }
    }
};
template <class Epi, class Sched, bool ALIGN_EPI = false, bool SP2 = false>
__device__ __forceinline__ void gemm_phase(PG8_LAS unsigned char* lds, const Gemm g, const Sched& S, const Epi& E) {
    const int tid = threadIdx.x, wid = __builtin_amdgcn_readfirstlane(tid >> 6), lane = tid & 63, wr = wid >> 2, wc = wid & 3, fr = lane & 15, fq = lane >> 4;
    const int K = g.K, nt = K / BK;
    unsigned voffA[2], voffB[2];
#pragma unroll
    for (int i = 0; i < 2; ++i) { int R, C; stage_rc(tid * 16 + i * 8192, R, C); const int Rb = Epi::PERM ? ((R & ~31) + perm32(R & 31)) : R;
        voffA[i] = (unsigned)(R * K + C) * 2u; voffB[i] = (unsigned)(Rb * K + C) * 2u; }
    const size_t kstep = (size_t)(BK * 2);
    const size_t hstep = (size_t)HALF * K * 2;
    const size_t tstep = 2 * hstep;
    const unsigned ldsw = (unsigned)wid * 1024u;
    const int aoff = lds_byte(wr * 64 + fr, fq * 8), boff = lds_byte(wc * 32 + fr, fq * 8);
#define PG8_SA(b, h) (((b) * 2 + (h)) * HTB)
#define PG8_SB(b, h) ((4 + (b) * 2 + (h)) * HTB)
#define PG8_STAGE(bufoff, gbase, voff) do { _Pragma("unroll") for (int _i = 0; _i < 2; ++_i) \
        __builtin_amdgcn_global_load_lds((const unsigned*)((const char*)(gbase) + (voff)[_i]), (PG8_LAS unsigned*)(lds + (bufoff) + ldsw + _i * 8192), 16, 0, 0); } while (0)
#define PG8_LDA(dst, b, h) do { _Pragma("unroll") for (int m = 0; m < 4; ++m) _Pragma("unroll") for (int k = 0; k < 2; ++k) dst[m][k] = *(const PG8_LAS bf16x8*)(lds + PG8_SA(b, h) + aoff + m * 2048 + k * 1024); } while (0)
#define PG8_LDB(dst, b, h) do { _Pragma("unroll") for (int n = 0; n < 2; ++n) _Pragma("unroll") for (int k = 0; k < 2; ++k) dst[n][k] = *(const PG8_LAS bf16x8*)(lds + PG8_SB(b, h) + boff + n * 2048 + k * 1024); } while (0)
#define PG8_MMA(ai, bj, At, Bt) do { __builtin_amdgcn_s_setprio(1); _Pragma("unroll") for (int m = 0; m < 4; ++m) _Pragma("unroll") for (int n = 0; n < 2; ++n) _Pragma("unroll") for (int k = 0; k < 2; ++k) \
        acc[ai][bj][m][n] = __builtin_amdgcn_mfma_f32_16x16x32_bf16(Bt[n][k], At[m][k], acc[ai][bj][m][n], 0, 0, 0); __builtin_amdgcn_s_setprio(0); } while (0)
#define PG8_WAIT_V(n) asm volatile("s_waitcnt vmcnt(" #n ")" ::: "memory")
#define PG8_WAIT_L(n) asm volatile("s_waitcnt lgkmcnt(" #n ")" ::: "memory")
#define PG8_BAR __builtin_amdgcn_s_barrier()
#define PG8_SCHED __builtin_amdgcn_sched_barrier(0)
    Unit cur, nxt; int ui = 0;
    if (!S.next(0, cur)) return;
    f32x4 acc[2][2][4][2];
#pragma unroll
    for (int a = 0; a < 2; ++a)
#pragma unroll
        for (int b = 0; b < 2; ++b)
#pragma unroll
            for (int m = 0; m < 4; ++m)
#pragma unroll
                for (int n = 0; n < 2; ++n) acc[a][b][m][n] = (f32x4){0.f, 0.f, 0.f, 0.f};
    bf16x8 At[4][2], B0[2][2], B1[2][2];
    const char* cA = (const char*)g.A + (size_t)cur.pm * tstep; const char* cB = (const char*)g.Bt + (size_t)cur.pn * tstep;
    S.a_ready(cur);
    if constexpr (SP2) {
        PG8_STAGE(PG8_SB(0, 0), cB, voffB); PG8_STAGE(PG8_SB(0, 1), cB + hstep, voffB); PG8_STAGE(PG8_SA(0, 0), cA, voffA); PG8_STAGE(PG8_SA(0, 1), cA + hstep, voffA);
        if (wr == 1) PG8_BAR;
        PG8_WAIT_V(2); PG8_BAR;
        PG8_STAGE(PG8_SB(1, 0), cB + kstep, voffB); PG8_STAGE(PG8_SA(1, 0), cA + kstep, voffA); PG8_STAGE(PG8_SB(1, 1), cB + hstep + kstep, voffB);
        PG8_WAIT_V(6); PG8_BAR;
    } else {
        PG8_STAGE(PG8_SB(0, 0), cB, voffB); PG8_STAGE(PG8_SA(0, 0), cA, voffA); PG8_STAGE(PG8_SB(0, 1), cB + hstep, voffB); PG8_STAGE(PG8_SA(0, 1), cA + hstep, voffA);
        if (wr == 1) PG8_BAR;
        PG8_WAIT_V(4); PG8_BAR;
        PG8_STAGE(PG8_SB(1, 0), cB + kstep, voffB); PG8_STAGE(PG8_SA(1, 0), cA + kstep, voffA); PG8_STAGE(PG8_SB(1, 1), cB + hstep + kstep, voffB);
        PG8_WAIT_V(6); PG8_BAR;
    }
    for (;;) {
        const bool has_next = S.next(ui + 1, nxt);
        const char* nA = has_next ? (const char*)g.A + (size_t)nxt.pm * tstep : cA; const char* nB = has_next ? (const char*)g.Bt + (size_t)nxt.pn * tstep : cB;
        for (int t = 0; t < nt; t += 2) {
            const bool last = (t == nt - 2);
            const char* a1 = cA + (size_t)(t + 1) * kstep;
            const char* a2 = last ? nA : cA + (size_t)(t + 2) * kstep; const char* b2 = last ? nB : cB + (size_t)(t + 2) * kstep;
            const char* a3 = a2 + kstep; const char* b3 = b2 + kstep;
            if (last && has_next) S.a_ready(nxt);
            if constexpr (SP2) {
            PG8_LDB(B0, 0, 0); PG8_LDB(B1, 0, 1); PG8_SCHED; PG8_LDA(At, 0, 0); PG8_STAGE(PG8_SA(1, 1), a1 + hstep, voffA);
            PG8_WAIT_V(8); PG8_WAIT_L(0); PG8_BAR; PG8_MMA(0, 0, At, B0); PG8_MMA(0, 1, At, B1); PG8_BAR; PG8_SCHED;
            PG8_LDA(At, 0, 1); PG8_STAGE(PG8_SB(0, 0), b2, voffB); PG8_STAGE(PG8_SB(0, 1), b2 + hstep, voffB); PG8_STAGE(PG8_SA(0, 0), a2, voffA);
            PG8_WAIT_V(8); PG8_WAIT_L(0); PG8_BAR; PG8_MMA(1, 0, At, B0); PG8_MMA(1, 1, At, B1); PG8_BAR; PG8_SCHED;
            PG8_LDB(B0, 1, 0); PG8_LDB(B1, 1, 1); PG8_SCHED; PG8_LDA(At, 1, 0); PG8_STAGE(PG8_SA(0, 1), a2 + hstep, voffA);
            PG8_WAIT_V(8); PG8_WAIT_L(0); PG8_BAR; PG8_MMA(0, 0, At, B0); PG8_MMA(0, 1, At, B1); PG8_BAR; PG8_SCHED;
            PG8_LDA(At, 1, 1); PG8_STAGE(PG8_SB(1, 0), b3, voffB); PG8_STAGE(PG8_SB(1, 1), b3 + hstep, voffB); PG8_STAGE(PG8_SA(1, 0), a3, voffA);
            PG8_WAIT_V(8); PG8_WAIT_L(0); PG8_BAR; PG8_MMA(1, 0, At, B0); PG8_MMA(1, 1, At, B1); PG8_BAR; PG8_SCHED;
            } else {
            PG8_LDB(B0, 0, 0); PG8_SCHED; PG8_LDA(At, 0, 0); PG8_STAGE(PG8_SA(1, 1), a1 + hstep, voffA);
            PG8_WAIT_L(8); PG8_BAR; PG8_WAIT_L(0); PG8_MMA(0, 0, At, B0); PG8_BAR; PG8_SCHED;
            PG8_LDB(B1, 0, 1); PG8_STAGE(PG8_SB(0, 0), b2, voffB);
            PG8_BAR; PG8_WAIT_L(0); PG8_MMA(0, 1, At, B1); PG8_BAR;
            PG8_LDA(At, 0, 1); PG8_STAGE(PG8_SA(0, 0), a2, voffA);
            PG8_BAR; PG8_WAIT_L(0); PG8_MMA(1, 0, At, B0); PG8_BAR; PG8_SCHED;
            PG8_STAGE(PG8_SB(0, 1), b2 + hstep, voffB);
            PG8_WAIT_V(6); PG8_BAR; PG8_MMA(1, 1, At, B1); PG8_BAR;
            PG8_LDB(B0, 1, 0); PG8_SCHED; PG8_LDA(At, 1, 0); PG8_STAGE(PG8_SA(0, 1), a2 + hstep, voffA);
            PG8_WAIT_L(8); PG8_BAR; PG8_WAIT_L(0); PG8_MMA(0, 0, At, B0); PG8_BAR; PG8_SCHED;
            PG8_LDB(B1, 1, 1); PG8_STAGE(PG8_SB(1, 0), b3, voffB);
            PG8_BAR; PG8_WAIT_L(0); PG8_MMA(0, 1, At, B1); PG8_BAR;
            PG8_LDA(At, 1, 1); PG8_STAGE(PG8_SA(1, 0), a3, voffA);
            PG8_BAR; PG8_WAIT_L(0); PG8_MMA(1, 0, At, B0); PG8_BAR; PG8_SCHED;
            PG8_STAGE(PG8_SB(1, 1), b3 + hstep, voffB);
            PG8_WAIT_V(6); PG8_BAR; PG8_MMA(1, 1, At, B1); PG8_BAR;
            }
        }
        if constexpr (ALIGN_EPI) { if (wr == 0) PG8_BAR; }
        if constexpr (!Epi::AFTER_DRAIN) { E(acc, cur, wr, wc, fr, fq); S.done(cur); }
        if (!has_next) break;
#pragma unroll
        for (int a = 0; a < 2; ++a)
#pragma unroll
            for (int b = 0; b < 2; ++b)
#pragma unroll
                for (int m = 0; m < 4; ++m)
#pragma unroll
                    for (int n = 0; n < 2; ++n) acc[a][b][m][n] = (f32x4){0.f, 0.f, 0.f, 0.f};
        cur = nxt; cA = nA; cB = nB; ++ui;
        if constexpr (ALIGN_EPI) { if (wr == 1) PG8_BAR; }
    }
    PG8_WAIT_V(0);
    if constexpr (!ALIGN_EPI) { if (wr == 0) PG8_BAR; }
    PG8_BAR;
    if constexpr (Epi::AFTER_DRAIN) { E.fused(acc, cur, wr, wc, fr, fq, lds, wid, lane); S.done(cur); }
#undef PG8_SA
#undef PG8_SB
#undef PG8_STAGE
#undef PG8_LDA
#undef PG8_LDB
#undef PG8_MMA
#undef PG8_WAIT_V
#undef PG8_WAIT_L
#undef PG8_BAR
#undef PG8_SCHED
}
}
__device__ __forceinline__ unsigned pk2(float lo, float hi) { return (unsigned)f2bf(lo) | ((unsigned)f2bf(hi) << 16); }
template <class CS>
__device__ __forceinline__ void transpose_item(const float* __restrict__ W, int K, int ldw, bf16_t* __restrict__ WT, int drow0, int k0, float* scr, int lane, const CS& csrc) {
    const int j = lane & 31; const int sc = csrc(j);
#pragma unroll 8
    for (int i = 0; i < 32; ++i) { const int kk = 2 * i + (lane >> 5); scr[kk * 33 + j] = sc >= 0 ? W[(size_t)(k0 + kk) * ldw + sc] : 0.f; }
    asm volatile("s_waitcnt lgkmcnt(0)" ::: "memory");
    const int c = lane & 7;
#pragma unroll
    for (int jj = 0; jj < 4; ++jj) { const int n = (lane >> 3) + 8 * jj; const float* s = scr + (8 * c) * 33 + n;
        uint4 o; o.x = pk2(s[0 * 33], s[1 * 33]); o.y = pk2(s[2 * 33], s[3 * 33]); o.z = pk2(s[4 * 33], s[5 * 33]); o.w = pk2(s[6 * 33], s[7 * 33]);
        *(uint4*)(WT + (size_t)(drow0 + n) * K + k0 + 8 * c) = o; }
    asm volatile("s_waitcnt lgkmcnt(0)" ::: "memory");
}
__device__ __forceinline__ void p0_phase(const Params& p, bf16_t* XB, bf16_t* WINT, bf16_t* WABT, bf16_t* WOT, unsigned char* lds) {
    const int lane = threadIdx.x & 63, wave = threadIdx.x >> 6;
    float* scr = (float*)(lds + wave * 8704);
    const int gw = blockIdx.x * 8 + wave, NGW = gridDim.x * 8;
    constexpr int I_IN = 32 * 376, I_AB = 16 * 64, I_O = 32 * 64;
    for (int it = gw; it < I_IN + 2 * I_AB + I_O; it += NGW) {
        int r = it;
        if (r < I_IN) { const int kb = r / 376, nb = r % 376, n0 = nb * 32;
            if (n0 < 11776) { const int s0 = n0 < 3072 ? n0 : (n0 < 6656 ? n0 + 8 : n0 + 32); transpose_item(p.in[1], 2048, INC, WINT, n0, kb * 64, scr, lane, [=](int j) { return s0 + j; }); }
            else if (n0 == 11776) transpose_item(p.in[1], 2048, INC, WINT, n0, kb * 64, scr, lane, [](int j) { return j < 8 ? 3072 + j : 6664 + (j - 8); });
            else transpose_item(p.in[1], 2048, INC, WINT, n0, kb * 64, scr, lane, [](int) { return -1; });
            continue; }
        r -= I_IN;
        if (r < I_AB) { const int kb = r / 64, n0 = (r % 64) * 32; transpose_item(p.in[9], 1024, 2048, WABT, n0, kb * 64, scr, lane, [=](int j) { return n0 + j; }); continue; }
        r -= I_AB;
        if (r < I_AB) { const int kb = r / 64, n0 = (r % 64) * 32; transpose_item(p.in[10], 1024, 2048, WABT, 2048 + n0, kb * 64, scr, lane, [=](int j) { return n0 + j; }); continue; }
        r -= I_AB;
        { const int kb = r / 64, n0 = (r % 64) * 32; transpose_item(p.in[11], 2048, 2048, WOT, n0, kb * 64, scr, lane, [=](int j) { return n0 + j; }); }
    }
    const float* x = p.in[0];
    for (size_t i = (size_t)blockIdx.x * NTHREADS + threadIdx.x; i < (size_t)M_ * D_ / 8; i += (size_t)gridDim.x * NTHREADS) {
        const float4 a = *(const float4*)(x + i * 8), b = *(const float4*)(x + i * 8 + 4);
        uint4 o; o.x = pk2(a.x, a.y); o.y = pk2(a.z, a.w); o.z = pk2(b.x, b.y); o.w = pk2(b.z, b.w);
        *(uint4*)(XB + i * 8) = o;
    }
}

__global__ void __launch_bounds__(NTHREADS, 2) fwd_megakernel(Params p) {
    extern __shared__ __attribute__((aligned(16))) unsigned char lds[];
    cg::grid_group grid = cg::this_grid();
    unsigned char* ws = p.ws;
    const float* x = p.in[0]; const float* b_f = p.in[2];
    const float* ln_g = p.in[12]; const float* ln_b = p.in[13]; const float* rel_bias = p.in[14];
    bf16_t* HB = (bf16_t*)(ws + WS_HB); float* LOGF = (float*)(ws + WS_LOGF); float* NGATE = (float*)(ws + WS_NGATE); float* CC = (float*)(ws + WS_CC);
    bf16_t* KCMP = (bf16_t*)(ws + WS_KCMP); bf16_t* VCMP = (bf16_t*)(ws + WS_VCMP); unsigned* SEL = (unsigned*)(ws + WS_SEL);
    bf16_t* OA = (bf16_t*)(ws + WS_OA); bf16_t* OB = (bf16_t*)(ws + WS_OB); bf16_t* MRG = (bf16_t*)(ws + WS_MRG);
    float* PC = (float*)(ws + WS_PC); float* OAF = (float*)(ws + WS_OAF); float* OBF = (float*)(ws + WS_OBF);

    bf16_t* XB = (bf16_t*)(ws + WS_XB); bf16_t* WINT = (bf16_t*)(ws + WS_WINT); bf16_t* WABT = (bf16_t*)(ws + WS_WABT); bf16_t* WOT = (bf16_t*)(ws + WS_WOT);
    PG8_LAS unsigned char* ldsl = (PG8_LAS unsigned char*)lds;
    p0_phase(p, XB, WINT, WABT, WOT, lds);
    grid.sync();
    { pg8::Gemm g{XB, WINT, M_, 12032, 2048}; pg8::StaticOrder S; S.init(M_, 12032, (int)gridDim.x, (int)blockIdx.x);
      pg8::EpiH1 E{HB, LOGF, NGATE, b_f};
      pg8::gemm_phase<pg8::EpiH1, pg8::StaticOrder, true, true>(ldsl, g, S, E); }
    grid.sync();
    cumsum_phase(LOGF, CC);
    compress_naive_phase(HB, p.in, KCMP, VCMP, lds);
    grid.sync();
    attn_naive_phase<0>(HB, CC, KCMP, VCMP, rel_bias, NGATE, SEL, PC, OAF, lds);
    attn_naive_phase<1>(HB, CC, KCMP, VCMP, rel_bias, NGATE, SEL, PC, OBF, lds);
    grid.sync();
    topk_naive_phase(PC, SEL);
    grid.sync();
    attn_naive_phase<2>(HB, CC, KCMP, VCMP, rel_bias, NGATE, SEL, PC, OBF, lds);
    attn_naive_phase<3>(HB, CC, KCMP, VCMP, rel_bias, NGATE, SEL, PC, OBF, lds);
    grid.sync();
    mulz_phase(OAF, HB, H_FZ, OA);
    mulz_phase(OBF, HB, H_NZ, OB);
    grid.sync();
    { pg8::Gemm g{OA, WABT, 2 * M_, 4096, 1024}; pg8::PairOrder S{(int)gridDim.x, (int)blockIdx.x};
      pg8::EpiMerge E{HB, (pg8::u32x4*)(ws + WS_T1B), MRG};
      pg8::gemm_phase<pg8::EpiMerge, pg8::PairOrder, true, true>(ldsl, g, S, E); }
    grid.sync();
    { pg8::Gemm g{MRG, WOT, M_, 2048, 2048}; pg8::StaticOrder S; S.init(M_, 2048, (int)gridDim.x, (int)blockIdx.x);
      pg8::EpiRes5 E{x, p.out};
      pg8::gemm_phase<pg8::EpiRes5, pg8::StaticOrder, true, true>(ldsl, g, S, E); }
    grid.sync();
    ln_phase(p.out, ln_g, ln_b, lds);
}
}

extern "C" void kernel_launch(void* const* d_in, const int* in_sizes, int n_in, void* d_out, int out_size, void* d_ws, size_t ws_size, hipStream_t stream) {
    static int grid_blocks = 0;
    if (grid_blocks == 0) {
        if (n_in != 15 || ws_size < WS_END || out_size != M_ * D_) { fprintf(stderr, "kernel_launch: unexpected shapes/ws (%d inputs, ws %zu, out %d)\n", n_in, ws_size, out_size); grid_blocks = -1; return; }
        int dev = 0, cus = 0, per_cu = 0;
        (void)hipGetDevice(&dev);
        (void)hipDeviceGetAttribute(&cus, hipDeviceAttributeMultiprocessorCount, dev);
        if (hipFuncSetAttribute((const void*)fwd_megakernel, hipFuncAttributeMaxDynamicSharedMemorySize, LDS_BYTES) != hipSuccess) { fprintf(stderr, "kernel_launch: hipFuncSetAttribute failed\n"); grid_blocks = -1; return; }
        (void)hipOccupancyMaxActiveBlocksPerMultiprocessor(&per_cu, (const void*)fwd_megakernel, NTHREADS, LDS_BYTES);
        if (per_cu < 1) { fprintf(stderr, "kernel_launch: occupancy query says %d blocks/CU\n", per_cu); grid_blocks = -1; return; }
        grid_blocks = cus;
        fprintf(stderr, "kernel_launch: %d CUs, occupancy %d/CU, grid %d, ws %zu\n", cus, per_cu, grid_blocks, ws_size);
    }
    if (grid_blocks < 0) return;
    (void)hipMemsetAsync((char*)d_ws + WS_CTL, 0, 65536, stream);
    Params p{};
    for (int i = 0; i < 15; ++i) p.in[i] = (const float*)d_in[i];
    p.out = (float*)d_out; p.ws = (unsigned char*)d_ws;
    void* args[] = {&p};
    hipError_t e = hipLaunchCooperativeKernel((const void*)fwd_megakernel, dim3(grid_blocks), dim3(NTHREADS), args, LDS_BYTES, stream);
    if (e != hipSuccess) fprintf(stderr, "cooperative launch failed: %s (grid %d)\n", hipGetErrorString(e), grid_blocks);
}
```

```cpp
#include <hip/hip_runtime.h>
#include <hip/hip_cooperative_groups.h>
#include <cstdio>
#include <cstdint>
namespace cg = cooperative_groups;

namespace {
constexpr int B_ = 4, S_ = 2048, D_ = 2048, M_ = B_ * S_;
constexpr int INC = 11808;
constexpr int NCMP = 127;
constexpr float SCALE = 0.08838834764831845f;
constexpr float ALPHA = 1.189207115002721f;
constexpr int PITCH = 11776;
constexpr int H_FQ = 0, H_FK = 1024, H_FV = 2048, H_FZ = 3072, H_NQ = 4096, H_KC = 5120, H_VC = 5376, H_KS = 5632, H_VS = 5888,
              H_KW = 6144, H_VW = 6400, H_NZ = 6656, H_GA = 7680, H_GB = 9728;
constexpr size_t MiB = 1u << 20;
constexpr size_t WS_CTL = 0;
constexpr size_t WS_HB = 1 * MiB;
constexpr size_t WS_CN = 185 * MiB;
constexpr size_t WS_LOGF = 186 * MiB;
constexpr size_t WS_NGATE = 187 * MiB;
constexpr size_t WS_CC = 188 * MiB;
constexpr size_t WS_KCMP = 189 * MiB;
constexpr size_t WS_VCMP = 190 * MiB;
constexpr size_t WS_SEL = 191 * MiB;
constexpr size_t WS_OA = 192 * MiB;
constexpr size_t WS_OB = 208 * MiB;
constexpr size_t WS_MRG = 224 * MiB;
constexpr size_t WS_PC = 256 * MiB;
constexpr size_t WS_OAF = 288 * MiB;
constexpr size_t WS_OBF = 320 * MiB;
constexpr size_t WS_XB = 256 * MiB;
constexpr size_t WS_WINT = 288 * MiB;
constexpr size_t WS_T1B = 256 * MiB;
constexpr size_t WS_WABT = 352 * MiB;
constexpr size_t WS_WOT = 360 * MiB;
constexpr size_t WS_END = 368 * MiB;

constexpr int NTHREADS = 512;
constexpr int LDS_BYTES = 147456;

typedef unsigned short bf16_t;
__device__ __forceinline__ float bf2f(bf16_t v) { return __uint_as_float((unsigned)v << 16); }
__device__ __forceinline__ bf16_t f2bf(float f) { unsigned u = __float_as_uint(f); return (bf16_t)((u + 0x7fffu + ((u >> 16) & 1u)) >> 16); }

__device__ __forceinline__ int tid_fresh(int wv) { int t = wv * 64 + (int)__builtin_amdgcn_mbcnt_hi(~0u, __builtin_amdgcn_mbcnt_lo(~0u, 0u)); asm volatile("" : "+v"(t)); return t; }
__device__ __forceinline__ int rel_bucket(int n) {
    if (n < 16) return n < 0 ? 0 : n;
    int b = 16;
    b += n >= 19; b += n >= 21; b += n >= 24; b += n >= 27; b += n >= 31; b += n >= 35; b += n >= 40; b += n >= 46;
    b += n >= 52; b += n >= 59; b += n >= 67; b += n >= 77; b += n >= 87; b += n >= 99; b += n >= 113;
    return b;
}
__device__ __forceinline__ float sigmoidf_(float v) { return 1.f / (1.f + expf(-v)); }
__device__ __forceinline__ float siluf_(float v) { return v / (1.f + expf(-v)); }
__device__ __forceinline__ float log_sigmoidf_(float v) { return fminf(v, 0.f) - log1pf(expf(-fabsf(v))); }
__device__ __forceinline__ float gelu_tanh(float v) { return 0.5f * v * (1.f + tanhf(0.7978845608028654f * (v + 0.044715f * v * v * v))); }

struct Params { const float* in[15]; float* out; unsigned char* ws; };

template <class TA> __device__ __forceinline__ float4 ld4(const TA* p);
template <> __device__ __forceinline__ float4 ld4<float>(const float* p) { return *(const float4*)p; }
template <> __device__ __forceinline__ float4 ld4<bf16_t>(const bf16_t* p) { const uint2 u = *(const uint2*)p; return make_float4(__uint_as_float(u.x << 16), __uint_as_float(u.x & 0xffff0000u), __uint_as_float(u.y << 16), __uint_as_float(u.y & 0xffff0000u)); }

template <class TA, class Epi>
__device__ __forceinline__ void gemm_naive_phase(int wv, const TA* __restrict__ A, const float* __restrict__ Bm, int lda, int ldb, int Mr, int N, int K, const Epi& epi, unsigned char* lds) {
    const int tf = tid_fresh(wv); const int half = tf >> 8, tid = tf & 255, tx = tid & 15, ty = tid >> 4;
    float (*As)[68] = (float (*)[68])(lds + half * 8704);
    float (*Bs)[68] = (float (*)[68])(lds + half * 8704 + 4352);
    const int ntn = (N + 63) / 64, nvb = (Mr / 64) * ntn, stride = gridDim.x * 2;
    const int iters = (nvb + stride - 1) / stride;
    const int ar = tid >> 2, ac = (tid & 3) * 4, br = tid >> 4, bc = (tid & 15) * 4;
    for (int it = 0; it < iters; ++it) {
        const int vb = it * stride + blockIdx.x * 2 + half;
        const bool act = vb < nvb;
        const int m0 = act ? (vb / ntn) * 64 : 0, n0 = act ? (vb % ntn) * 64 : 0;
        float acc[4][4];
#pragma unroll
        for (int i = 0; i < 4; ++i)
#pragma unroll
            for (int j = 0; j < 4; ++j) acc[i][j] = 0.f;
        for (int k0 = 0; k0 < K; k0 += 16) {
            const float4 a = ld4<TA>(A + (size_t)(m0 + ar) * lda + k0 + ac);
            As[ac + 0][ar] = a.x; As[ac + 1][ar] = a.y; As[ac + 2][ar] = a.z; As[ac + 3][ar] = a.w;
            float4 b = make_float4(0.f, 0.f, 0.f, 0.f);
            if (n0 + bc < N) b = *(const float4*)(Bm + (size_t)(k0 + br) * ldb + n0 + bc);
            *(float4*)&Bs[br][bc] = b;
            __syncthreads();
#pragma unroll
            for (int kk = 0; kk < 16; ++kk) {
                const float4 av = *(const float4*)&As[kk][ty * 4];
                const float4 bv = *(const float4*)&Bs[kk][tx * 4];
                const float aa[4] = {av.x, av.y, av.z, av.w}, bb[4] = {bv.x, bv.y, bv.z, bv.w};
#pragma unroll
                for (int i = 0; i < 4; ++i)
#pragma unroll
                    for (int j = 0; j < 4; ++j) acc[i][j] += aa[i] * bb[j];
            }
            __syncthreads();
        }
        if (act) {
#pragma unroll
            for (int i = 0; i < 4; ++i)
#pragma unroll
                for (int j = 0; j < 4; ++j) { const int n = n0 + tx * 4 + j; if (n < N) epi(m0 + ty * 4 + i, n, acc[i][j]); }
        }
    }
}
struct EpiH {
    bf16_t* HB; float* LOGF; float* NGATE; const float* b_f;
    __device__ __forceinline__ void operator()(int m, int n, float a) const {
        if (n < 3072) HB[(size_t)m * PITCH + n] = f2bf(a);
        else if (n < 3080) LOGF[(size_t)m * 8 + (n - 3072)] = log_sigmoidf_(a + b_f[n - 3072]);
        else if (n < 4104) HB[(size_t)m * PITCH + n - 8] = f2bf(siluf_(a));
        else if (n < 6664) HB[(size_t)m * PITCH + n - 8] = f2bf(a);
        else if (n < 6688) NGATE[(size_t)m * 24 + (n - 6664)] = sigmoidf_(a);
        else if (n < 7712) HB[(size_t)m * PITCH + n - 32] = f2bf(siluf_(a));
        else HB[(size_t)m * PITCH + n - 32] = f2bf(sigmoidf_(a));
    }
};
struct EpiGateA { const bf16_t* HB; float* T1; __device__ __forceinline__ void operator()(int m, int n, float a) const { T1[(size_t)m * 2048 + n] = bf2f(HB[(size_t)m * PITCH + H_GA + n]) * a; } };
struct EpiGateB { const bf16_t* HB; const float* T1; bf16_t* MRG; __device__ __forceinline__ void operator()(int m, int n, float a) const { MRG[(size_t)m * 2048 + n] = f2bf(T1[(size_t)m * 2048 + n] + bf2f(HB[(size_t)m * PITCH + H_GB + n]) * a); } };
struct EpiRes { const float* X; float* O; __device__ __forceinline__ void operator()(int m, int n, float a) const { O[(size_t)m * D_ + n] = ALPHA * X[(size_t)m * D_ + n] + a; } };

__device__ __forceinline__ void cumsum_phase(int wv, const float* __restrict__ LOGF, bf16_t* __restrict__ CN) {
    const int tx = tid_fresh(wv); const int lane = tx & 63, gw = blockIdx.x * (NTHREADS / 64) + (tx >> 6);
    if (gw >= B_ * 8) return;
    const int b = gw >> 3, h = gw & 7;
    double run = 0.0;
    for (int i = 0; i < 32; ++i) run += (double)LOGF[(size_t)(b * S_ + lane * 32 + i) * 8 + h];
    double incl = run;
#pragma unroll
    for (int o = 1; o < 64; o <<= 1) { const double v = __shfl_up(incl, o); if (lane >= o) incl += v; }
    double base = incl - run;
    for (int i = 0; i < 32; ++i) { base += (double)LOGF[(size_t)(b * S_ + lane * 32 + i) * 8 + h];         { const float v = (float)(-base * 11.313708498984761); const bf16_t h0 = f2bf(v); const float r1 = v - bf2f(h0); const bf16_t h1 = f2bf(r1); const bf16_t h2 = f2bf(r1 - bf2f(h1));
          uint4 w; w.x = (unsigned)h0 | ((unsigned)h1 << 16); w.y = (unsigned)h2; w.z = 0u; w.w = 0u; *(uint4*)(CN + ((size_t)gw * S_ + lane * 32 + i) * 8) = w; } }
}

__device__ __forceinline__ void compress_naive_phase(int wv, const bf16_t* __restrict__ HB, const float* const* in, bf16_t* KCMP, bf16_t* VCMP, unsigned char* lds) {
    const int tx = tid_fresh(wv); const int half = tx >> 8, tid = tx & 255;
    float* flat = (float*)(lds + half * 18432);
    float* hid = flat + 4096;
    const int nvb = 2 * B_ * 128 * 2, stride = gridDim.x * 2, iters = (nvb + stride - 1) / stride;
    for (int it = 0; it < iters; ++it) {
        const int vb = it * stride + blockIdx.x * 2 + half;
        const bool act = vb < nvb;
        const int kv = vb & 1, g = (vb >> 1) & 1, c = (vb >> 2) & 127, b = (vb >> 9) & 3;
        const float* pos = in[3 + kv]; const float* w1 = in[kv ? 7 : 5]; const float* w2 = in[kv ? 8 : 6];
        bf16_t* out = (kv ? VCMP : KCMP) + (size_t)((b * 2 + g) * 128 + c) * 128;
        const bool real = act && c < NCMP;
        if (real) for (int i = tid; i < 4096; i += 256) { const int l = i >> 7, d = i & 127;
            flat[i] = bf2f(HB[(size_t)(b * S_ + 16 * c + l) * PITCH + (kv ? H_VC : H_KC) + g * 128 + d]) + pos[l * 128 + d]; }
        __syncthreads();
        float a = 0.f;
        if (real) { for (int k = 0; k < 4096; ++k) a += flat[k] * w1[(size_t)k * 256 + tid]; hid[tid] = gelu_tanh(a); }
        __syncthreads();
        if (act && tid < 128) {
            float o = 0.f;
            if (real) for (int n = 0; n < 256; ++n) o += hid[n] * w2[n * 128 + tid];
            out[tid] = f2bf(o);
        }
        __syncthreads();
    }
}

__device__ __forceinline__ void ln_phase(int wv, float* __restrict__ X, const float* __restrict__ g, const float* __restrict__ bta, unsigned char* lds) {
    const int tx = tid_fresh(wv); const int half = tx >> 8, tid = tx & 255;
    float* red = (float*)(lds + half * 1024);
    for (int r0 = blockIdx.x * 2; r0 < M_; r0 += gridDim.x * 2) {
        float* xr = X + (size_t)(r0 + half) * D_;
        float v[8]; float s = 0.f;
#pragma unroll
        for (int i = 0; i < 8; ++i) { v[i] = xr[tid + 256 * i]; s += v[i]; }
        red[tid] = s; __syncthreads();
        for (int o = 128; o > 0; o >>= 1) { if (tid < o) red[tid] += red[tid + o]; __syncthreads(); }
        const float mean = red[0] * (1.f / D_); __syncthreads();
        float q = 0.f;
#pragma unroll
        for (int i = 0; i < 8; ++i) { v[i] -= mean; q += v[i] * v[i]; }
        red[tid] = q; __syncthreads();
        for (int o = 128; o > 0; o >>= 1) { if (tid < o) red[tid] += red[tid + o]; __syncthreads(); }
        const float rstd = rsqrtf(red[0] * (1.f / D_) + 1e-5f);
        __syncthreads();
#pragma unroll
        for (int i = 0; i < 8; ++i) xr[tid + 256 * i] = v[i] * rstd * g[tid + 256 * i] + bta[tid + 256 * i];
    }
}


namespace pg8 {
#define PG8_LAS __attribute__((address_space(3)))
typedef unsigned short bf16_t;
typedef short bf16x8 __attribute__((ext_vector_type(8)));
typedef float f32x4 __attribute__((ext_vector_type(4)));
typedef unsigned u32x4 __attribute__((ext_vector_type(4)));
constexpr int BM = 256, BK = 64, HALF = 128, HTB = HALF * BK * 2  , STAGE_BYTES = 8 * HTB, NXCD = 8, WGM = 8;

__host__ __device__ __forceinline__ int lds_byte(int r, int c) { const int st = (r >> 4) * 2 + (c >> 5), rr = r & 15, cc = c & 31, ob = rr * 64 + cc * 2; return st * 1024 + (ob ^ (((ob >> 9) & 1) << 5)); }
__host__ __device__ __forceinline__ void stage_rc(int b, int& R, int& C) { const int st = b / 1024, sb = b % 1024, swz = sb ^ (((sb >> 9) & 1) << 5); R = (st >> 1) * 16 + swz / 64; C = (st & 1) * 32 + (swz % 64) / 2; }
__host__ __device__ __forceinline__ int perm32(int rho) { const int n = rho >> 4, i = rho & 15; return 8 * (i >> 2) + 4 * n + (i & 3); }

struct Unit { int pm, pn; };
struct Gemm { const bf16_t* A; const bf16_t* Bt; int M, N, K; };

struct StaticOrder {
    int nM, nN, nwg, G, c;
    __host__ __device__ void init(int M, int N, int G_, int c_) { nM = M / BM; nN = N / BM; nwg = nM * nN; G = G_; c = c_; }
    __host__ __device__ bool next(int i, Unit& u) const {
        const long L = (long)i * G + c; if (L >= nwg) return false;
        int wgid = (int)L; { const int q = nwg / NXCD, r = nwg % NXCD, xcd = wgid % NXCD, off = wgid / NXCD; wgid = (xcd < r ? xcd * (q + 1) : r * (q + 1) + (xcd - r) * q) + off; }
        const int nig = WGM * nN, gid = wgid / nig, fm = gid * WGM, gsz = (nM - fm) < WGM ? (nM - fm) : WGM;
        u.pm = fm + ((wgid % nig) % gsz); u.pn = (wgid % nig) / gsz; return true;
    }
    __device__ __forceinline__ void a_ready(const Unit&) const {}
    __device__ __forceinline__ void done(const Unit&) const {}
};

__device__ __forceinline__ unsigned cvt_pk_bf16(float lo, float hi) { unsigned r; asm volatile("v_cvt_pk_bf16_f32 %0, %1, %2" : "=v"(r) : "v"(lo), "v"(hi)); return r; }
__device__ __forceinline__ float fast_sigmoid(float v) { return __builtin_amdgcn_rcpf(1.f + __builtin_amdgcn_exp2f(-1.4426950408889634f * v)); }
__device__ __forceinline__ f32x4 act4(f32x4 v, int act) {
    if (act == 0) return v;
    f32x4 s; s[0] = fast_sigmoid(v[0]); s[1] = fast_sigmoid(v[1]); s[2] = fast_sigmoid(v[2]); s[3] = fast_sigmoid(v[3]);
    return act == 1 ? v * s : s;
}
struct EpiH1 {
    static constexpr bool PERM = true, AFTER_DRAIN = false;
    bf16_t* HB; float* LOGF; float* NGATE; const float* b_f;
    __device__ __forceinline__ void operator()(const f32x4 (&acc)[2][2][4][2], const Unit& u, int wr, int wc, int fr, int fq) const {
        const int row0 = u.pm * BM + wr * 64 + fr;
        if (u.pn < 46) {
            const int act = ((u.pn >= 12 && u.pn < 16) || (u.pn >= 26 && u.pn < 30)) ? 1 : (u.pn >= 30 ? 2 : 0);
            const int col0 = u.pn * BM + wc * 32 + 8 * fq;
#pragma unroll
            for (int ai = 0; ai < 2; ++ai)
#pragma unroll
                for (int m = 0; m < 4; ++m) { bf16_t* rowp = HB + (size_t)(row0 + ai * HALF + m * 16) * 11776 + col0;
#pragma unroll
                    for (int bj = 0; bj < 2; ++bj) { const f32x4 v0 = act4(acc[ai][bj][m][0], act), v1 = act4(acc[ai][bj][m][1], act);
                        u32x4 w; w.x = cvt_pk_bf16(v0[0], v0[1]); w.y = cvt_pk_bf16(v0[2], v0[3]); w.z = cvt_pk_bf16(v1[0], v1[1]); w.w = cvt_pk_bf16(v1[2], v1[3]);
                        *(u32x4*)(rowp + bj * HALF) = w; } }
        } else if (wc == 0) {
#pragma unroll
            for (int ai = 0; ai < 2; ++ai)
#pragma unroll
                for (int m = 0; m < 4; ++m) { const size_t row = (size_t)(row0 + ai * HALF + m * 16);
#pragma unroll
                    for (int n = 0; n < 2; ++n) { const f32x4 v = acc[ai][0][m][n];
                        if (fq == 0) { f32x4 o;
#pragma unroll
                            for (int e = 0; e < 4; ++e) { const float t = v[e] + b_f[4 * n + e]; o[e] = fminf(t, 0.f) - 0.6931471805599453f * __builtin_amdgcn_logf(1.f + __builtin_amdgcn_exp2f(-1.4426950408889634f * fabsf(t))); }
                            *(f32x4*)(LOGF + row * 8 + 4 * n) = o; }
                        else { f32x4 o;
#pragma unroll
                            for (int e = 0; e < 4; ++e) o[e] = fast_sigmoid(v[e]);
                            *(f32x4*)(NGATE + row * 24 + 8 * fq + 4 * n - 8) = o; } } }
        }
    }
};
struct EpiMerge {
    static constexpr bool PERM = true, AFTER_DRAIN = false;
    const bf16_t* HB; u32x4* T1; bf16_t* MRG;
    __device__ __forceinline__ void operator()(const f32x4 (&acc)[2][2][4][2], const Unit& u, int wr, int wc, int fr, int fq) const {
        const int pass = u.pm >> 5, pm = u.pm & 31, pn = u.pn & 7;
        const int row0 = pm * BM + wr * 64 + fr, col0 = pn * BM + wc * 32 + 8 * fq;
        u32x4* t1 = T1 + (size_t)(pm * 8 + pn) * (16 * 512) + (wr * 4 + wc) * 64 + fq * 16 + fr;
        const int gcol = (pass ? 9728 : 7680) + col0;
#pragma unroll
        for (int ai = 0; ai < 2; ++ai)
#pragma unroll
            for (int m = 0; m < 4; ++m) { const size_t row = (size_t)(row0 + ai * HALF + m * 16);
#pragma unroll
                for (int bj = 0; bj < 2; ++bj) {
                    const u32x4 gw = *(const u32x4*)(HB + row * 11776 + gcol + bj * HALF);
                    f32x4 g0, g1; g0[0] = __uint_as_float(gw.x << 16); g0[1] = __uint_as_float(gw.x & 0xffff0000u); g0[2] = __uint_as_float(gw.y << 16); g0[3] = __uint_as_float(gw.y & 0xffff0000u);
                    g1[0] = __uint_as_float(gw.z << 16); g1[1] = __uint_as_float(gw.z & 0xffff0000u); g1[2] = __uint_as_float(gw.w << 16); g1[3] = __uint_as_float(gw.w & 0xffff0000u);
                    f32x4 v0 = acc[ai][bj][m][0] * g0, v1 = acc[ai][bj][m][1] * g1;
                    u32x4* tp = t1 + (size_t)((ai * 4 + m) * 2 + bj) * 512;
                    if (pass) { const u32x4 tw = *tp;
                        v0[0] += __uint_as_float(tw.x << 16); v0[1] += __uint_as_float(tw.x & 0xffff0000u); v0[2] += __uint_as_float(tw.y << 16); v0[3] += __uint_as_float(tw.y & 0xffff0000u);
                        v1[0] += __uint_as_float(tw.z << 16); v1[1] += __uint_as_float(tw.z & 0xffff0000u); v1[2] += __uint_as_float(tw.w << 16); v1[3] += __uint_as_float(tw.w & 0xffff0000u); }
                    u32x4 w; w.x = cvt_pk_bf16(v0[0], v0[1]); w.y = cvt_pk_bf16(v0[2], v0[3]); w.z = cvt_pk_bf16(v1[0], v1[1]); w.w = cvt_pk_bf16(v1[2], v1[3]);
                    if (pass) *(u32x4*)(MRG + row * 2048 + col0 + bj * HALF) = w; else *tp = w; } }
    }
};
struct PairOrder {
    int G, c;
    __device__ __forceinline__ bool next(int i, Unit& u) const {
        StaticOrder s; s.init(8192, 2048, G, c);
        if (!s.next(i >> 1, u)) return false;
        const int pass = i & 1; u.pm += 32 * pass; u.pn += 8 * pass; return true;
    }
    __device__ __forceinline__ void a_ready(const Unit&) const {}
    __device__ __forceinline__ void done(const Unit&) const {}
};
struct EpiRes5 {
    static constexpr bool PERM = false, AFTER_DRAIN = false;
    const float* X; float* O;
    __device__ __forceinline__ void operator()(const f32x4 (&acc)[2][2][4][2], const Unit& u, int wr, int wc, int fr, int fq) const {
        const int row0 = u.pm * BM + wr * 64 + fr, col0 = u.pn * BM + wc * 32 + 4 * fq;
#pragma unroll
        for (int ai = 0; ai < 2; ++ai)
#pragma unroll
            for (int m = 0; m < 4; ++m) { const size_t off = (size_t)(row0 + ai * HALF + m * 16) * 2048 + col0;
#pragma unroll
                for (int bj = 0; bj < 2; ++bj)
#pragma unroll
                    for (int n = 0; n < 2; ++n) { const f32x4 xv = *(const f32x4*)(X + off + bj * HALF + n * 16);
                        *(f32x4*)(O + off + bj * HALF + n * 16) = xv * 1.189207115002721f + acc[ai][bj][m][n]; } }
    }
};
template <class Epi, class Sched, bool ALIGN_EPI = false, bool SP2 = false>
__device__ __forceinline__ void gemm_phase(int wv, PG8_LAS unsigned char* lds, const Gemm g, const Sched& S, const Epi& E) {
    int tid_ = tid_fresh(wv);
    const int tid = tid_, wid = wv, lane = tid & 63, wr = wid >> 2, wc = wid & 3, fr = lane & 15, fq = lane >> 4;
    const int K = g.K, nt = K / BK;
    unsigned voffA[2], voffB[2];
#pragma unroll
    for (int i = 0; i < 2; ++i) { int R, C; stage_rc(tid * 16 + i * 8192, R, C); const int Rb = Epi::PERM ? ((R & ~31) + perm32(R & 31)) : R;
        voffA[i] = (unsigned)(R * K + C) * 2u; voffB[i] = (unsigned)(Rb * K + C) * 2u; }
    const size_t kstep = (size_t)(BK * 2);
    const size_t hstep = (size_t)HALF * K * 2;
    const size_t tstep = 2 * hstep;
    const unsigned ldsw = (unsigned)wid * 1024u;
    const int aoff = lds_byte(wr * 64 + fr, fq * 8), boff = lds_byte(wc * 32 + fr, fq * 8);
#define PG8_SA(b, h) (((b) * 2 + (h)) * HTB)
#define PG8_SB(b, h) ((4 + (b) * 2 + (h)) * HTB)
#define PG8_STAGE(bufoff, gbase, voff) do { _Pragma("unroll") for (int _i = 0; _i < 2; ++_i) \
        __builtin_amdgcn_global_load_lds((const unsigned*)((const char*)(gbase) + (voff)[_i]), (PG8_LAS unsigned*)(lds + (bufoff) + ldsw + _i * 8192), 16, 0, 0); } while (0)
#define PG8_LDA(dst, b, h) do { _Pragma("unroll") for (int m = 0; m < 4; ++m) _Pragma("unroll") for (int k = 0; k < 2; ++k) dst[m][k] = *(const PG8_LAS bf16x8*)(lds + PG8_SA(b, h) + aoff + m * 2048 + k * 1024); } while (0)
#define PG8_LDB(dst, b, h) do { _Pragma("unroll") for (int n = 0; n < 2; ++n) _Pragma("unroll") for (int k = 0; k < 2; ++k) dst[n][k] = *(const PG8_LAS bf16x8*)(lds + PG8_SB(b, h) + boff + n * 2048 + k * 1024); } while (0)
#define PG8_MMA(ai, bj, At, Bt) do { __builtin_amdgcn_s_setprio(1); _Pragma("unroll") for (int m = 0; m < 4; ++m) _Pragma("unroll") for (int n = 0; n < 2; ++n) _Pragma("unroll") for (int k = 0; k < 2; ++k) \
        acc[ai][bj][m][n] = __builtin_amdgcn_mfma_f32_16x16x32_bf16(Bt[n][k], At[m][k], acc[ai][bj][m][n], 0, 0, 0); __builtin_amdgcn_s_setprio(0); } while (0)
#define PG8_WAIT_V(n) asm volatile("s_waitcnt vmcnt(" #n ")" ::: "memory")
#define PG8_WAIT_L(n) asm volatile("s_waitcnt lgkmcnt(" #n ")" ::: "memory")
#define PG8_BAR __builtin_amdgcn_s_barrier()
#define PG8_SCHED __builtin_amdgcn_sched_barrier(0)
    Unit cur, nxt; int ui = 0;
    if (!S.next(0, cur)) return;
    f32x4 acc[2][2][4][2];
#pragma unroll
    for (int a = 0; a < 2; ++a)
#pragma unroll
        for (int b = 0; b < 2; ++b)
#pragma unroll
            for (int m = 0; m < 4; ++m)
#pragma unroll
                for (int n = 0; n < 2; ++n) acc[a][b][m][n] = (f32x4){0.f, 0.f, 0.f, 0.f};
    bf16x8 At[4][2], B0[2][2], B1[2][2];
    const char* cA = (const char*)g.A + (size_t)cur.pm * tstep; const char* cB = (const char*)g.Bt + (size_t)cur.pn * tstep;
    S.a_ready(cur);
    if constexpr (SP2) {
        PG8_STAGE(PG8_SB(0, 0), cB, voffB); PG8_STAGE(PG8_SB(0, 1), cB + hstep, voffB); PG8_STAGE(PG8_SA(0, 0), cA, voffA); PG8_STAGE(PG8_SA(0, 1), cA + hstep, voffA);
        if (wr == 1) PG8_BAR;
        PG8_WAIT_V(2); PG8_BAR;
        PG8_STAGE(PG8_SB(1, 0), cB + kstep, voffB); PG8_STAGE(PG8_SA(1, 0), cA + kstep, voffA); PG8_STAGE(PG8_SB(1, 1), cB + hstep + kstep, voffB);
        PG8_WAIT_V(6); PG8_BAR;
    } else {
        PG8_STAGE(PG8_SB(0, 0), cB, voffB); PG8_STAGE(PG8_SA(0, 0), cA, voffA); PG8_STAGE(PG8_SB(0, 1), cB + hstep, voffB); PG8_STAGE(PG8_SA(0, 1), cA + hstep, voffA);
        if (wr == 1) PG8_BAR;
        PG8_WAIT_V(4); PG8_BAR;
        PG8_STAGE(PG8_SB(1, 0), cB + kstep, voffB); PG8_STAGE(PG8_SA(1, 0), cA + kstep, voffA); PG8_STAGE(PG8_SB(1, 1), cB + hstep + kstep, voffB);
        PG8_WAIT_V(6); PG8_BAR;
    }
    for (;;) {
        const bool has_next = S.next(ui + 1, nxt);
        const char* nA = has_next ? (const char*)g.A + (size_t)nxt.pm * tstep : cA; const char* nB = has_next ? (const char*)g.Bt + (size_t)nxt.pn * tstep : cB;
        for (int t = 0; t < nt; t += 2) {
            const bool last = (t == nt - 2);
            const char* a1 = cA + (size_t)(t + 1) * kstep;
            const char* a2 = last ? nA : cA + (size_t)(t + 2) * kstep; const char* b2 = last ? nB : cB + (size_t)(t + 2) * kstep;
            const char* a3 = a2 + kstep; const char* b3 = b2 + kstep;
            if (last && has_next) S.a_ready(nxt);
            if constexpr (SP2) {
            PG8_LDB(B0, 0, 0); PG8_LDB(B1, 0, 1); PG8_SCHED; PG8_LDA(At, 0, 0); PG8_STAGE(PG8_SA(1, 1), a1 + hstep, voffA);
            PG8_WAIT_V(8); PG8_WAIT_L(0); PG8_BAR; PG8_MMA(0, 0, At, B0); PG8_MMA(0, 1, At, B1); PG8_BAR; PG8_SCHED;
            PG8_LDA(At, 0, 1); PG8_STAGE(PG8_SB(0, 0), b2, voffB); PG8_STAGE(PG8_SB(0, 1), b2 + hstep, voffB); PG8_STAGE(PG8_SA(0, 0), a2, voffA);
            PG8_WAIT_V(8); PG8_WAIT_L(0); PG8_BAR; PG8_MMA(1, 0, At, B0); PG8_MMA(1, 1, At, B1); PG8_BAR; PG8_SCHED;
            PG8_LDB(B0, 1, 0); PG8_LDB(B1, 1, 1); PG8_SCHED; PG8_LDA(At, 1, 0); PG8_STAGE(PG8_SA(0, 1), a2 + hstep, voffA);
            PG8_WAIT_V(8); PG8_WAIT_L(0); PG8_BAR; PG8_MMA(0, 0, At, B0); PG8_MMA(0, 1, At, B1); PG8_BAR; PG8_SCHED;
            PG8_LDA(At, 1, 1); PG8_STAGE(PG8_SB(1, 0), b3, voffB); PG8_STAGE(PG8_SB(1, 1), b3 + hstep, voffB); PG8_STAGE(PG8_SA(1, 0), a3, voffA);
            PG8_WAIT_V(8); PG8_WAIT_L(0); PG8_BAR; PG8_MMA(1, 0, At, B0); PG8_MMA(1, 1, At, B1); PG8_BAR; PG8_SCHED;
            } else {
            PG8_LDB(B0, 0, 0); PG8_SCHED; PG8_LDA(At, 0, 0); PG8_STAGE(PG8_SA(1, 1), a1 + hstep, voffA);
            PG8_WAIT_L(8); PG8_BAR; PG8_WAIT_L(0); PG8_MMA(0, 0, At, B0); PG8_BAR; PG8_SCHED;
            PG8_LDB(B1, 0, 1); PG8_STAGE(PG8_SB(0, 0), b2, voffB);
            PG8_BAR; PG8_WAIT_L(0); PG8_MMA(0, 1, At, B1); PG8_BAR;
            PG8_LDA(At, 0, 1); PG8_STAGE(PG8_SA(0, 0), a2, voffA);
            PG8_BAR; PG8_WAIT_L(0); PG8_MMA(1, 0, At, B0); PG8_BAR; PG8_SCHED;
            PG8_STAGE(PG8_SB(0, 1), b2 + hstep, voffB);
            PG8_WAIT_V(6); PG8_BAR; PG8_MMA(1, 1, At, B1); PG8_BAR;
            PG8_LDB(B0, 1, 0); PG8_SCHED; PG8_LDA(At, 1, 0); PG8_STAGE(PG8_SA(0, 1), a2 + hstep, voffA);
            PG8_WAIT_L(8); PG8_BAR; PG8_WAIT_L(0); PG8_MMA(0, 0, At, B0); PG8_BAR; PG8_SCHED;
            PG8_LDB(B1, 1, 1); PG8_STAGE(PG8_SB(1, 0), b3, voffB);
            PG8_BAR; PG8_WAIT_L(0); PG8_MMA(0, 1, At, B1); PG8_BAR;
            PG8_LDA(At, 1, 1); PG8_STAGE(PG8_SA(1, 0), a3, voffA);
            PG8_BAR; PG8_WAIT_L(0); PG8_MMA(1, 0, At, B0); PG8_BAR; PG8_SCHED;
            PG8_STAGE(PG8_SB(1, 1), b3 + hstep, voffB);
            PG8_WAIT_V(6); PG8_BAR; PG8_MMA(1, 1, At, B1); PG8_BAR;
            }
        }
        if constexpr (ALIGN_EPI) { if (wr == 0) PG8_BAR; }
        if constexpr (!Epi::AFTER_DRAIN) { E(acc, cur, wr, wc, fr, fq); S.done(cur); }
        if (!has_next) break;
#pragma unroll
        for (int a = 0; a < 2; ++a)
#pragma unroll
            for (int b = 0; b < 2; ++b)
#pragma unroll
                for (int m = 0; m < 4; ++m)
#pragma unroll
                    for (int n = 0; n < 2; ++n) acc[a][b][m][n] = (f32x4){0.f, 0.f, 0.f, 0.f};
        cur = nxt; cA = nA; cB = nB; ++ui;
        if constexpr (ALIGN_EPI) { if (wr == 1) PG8_BAR; }
    }
    PG8_WAIT_V(0);
    if constexpr (!ALIGN_EPI) { if (wr == 0) PG8_BAR; }
    PG8_BAR;
    if constexpr (Epi::AFTER_DRAIN) { E.fused(acc, cur, wr, wc, fr, fq, lds, wid, lane); S.done(cur); }
#undef PG8_SA
#undef PG8_SB
#undef PG8_STAGE
#undef PG8_LDA
#undef PG8_LDB
#undef PG8_MMA
#undef PG8_WAIT_V
#undef PG8_WAIT_L
#undef PG8_BAR
#undef PG8_SCHED
}
}
__device__ __forceinline__ unsigned pk2(float lo, float hi) { return (unsigned)f2bf(lo) | ((unsigned)f2bf(hi) << 16); }
template <class CS>
__device__ __forceinline__ void transpose_item(const float* __restrict__ W, int K, int ldw, bf16_t* __restrict__ WT, int drow0, int k0, float* scr, int lane, const CS& csrc) {
    const int j = lane & 31; const int sc = csrc(j);
#pragma unroll 8
    for (int i = 0; i < 32; ++i) { const int kk = 2 * i + (lane >> 5); scr[kk * 33 + j] = sc >= 0 ? W[(size_t)(k0 + kk) * ldw + sc] : 0.f; }
    asm volatile("s_waitcnt lgkmcnt(0)" ::: "memory");
    const int c = lane & 7;
#pragma unroll
    for (int jj = 0; jj < 4; ++jj) { const int n = (lane >> 3) + 8 * jj; const float* s = scr + (8 * c) * 33 + n;
        uint4 o; o.x = pk2(s[0 * 33], s[1 * 33]); o.y = pk2(s[2 * 33], s[3 * 33]); o.z = pk2(s[4 * 33], s[5 * 33]); o.w = pk2(s[6 * 33], s[7 * 33]);
        *(uint4*)(WT + (size_t)(drow0 + n) * K + k0 + 8 * c) = o; }
    asm volatile("s_waitcnt lgkmcnt(0)" ::: "memory");
}
__device__ __forceinline__ void p0_phase(int wv, const Params& p, bf16_t* XB, bf16_t* WINT, bf16_t* WABT, bf16_t* WOT, unsigned char* lds) {
    const int tx = tid_fresh(wv); const int lane = tx & 63, wave = tx >> 6;
    float* scr = (float*)(lds + wave * 8704);
    const int gw = blockIdx.x * 8 + wave, NGW = gridDim.x * 8;
    constexpr int I_IN = 32 * 376, I_AB = 16 * 64, I_O = 32 * 64;
    for (int it = gw; it < I_IN + 2 * I_AB + I_O; it += NGW) {
        int r = it;
        if (r < I_IN) { const int kb = r / 376, nb = r % 376, n0 = nb * 32;
            if (n0 < 11776) { const int s0 = n0 < 3072 ? n0 : (n0 < 6656 ? n0 + 8 : n0 + 32); transpose_item(p.in[1], 2048, INC, WINT, n0, kb * 64, scr, lane, [=](int j) { return s0 + j; }); }
            else if (n0 == 11776) transpose_item(p.in[1], 2048, INC, WINT, n0, kb * 64, scr, lane, [](int j) { return j < 8 ? 3072 + j : 6664 + (j - 8); });
            else transpose_item(p.in[1], 2048, INC, WINT, n0, kb * 64, scr, lane, [](int) { return -1; });
            continue; }
        r -= I_IN;
        if (r < I_AB) { const int kb = r / 64, n0 = (r % 64) * 32; transpose_item(p.in[9], 1024, 2048, WABT, n0, kb * 64, scr, lane, [=](int j) { return n0 + j; }); continue; }
        r -= I_AB;
        if (r < I_AB) { const int kb = r / 64, n0 = (r % 64) * 32; transpose_item(p.in[10], 1024, 2048, WABT, 2048 + n0, kb * 64, scr, lane, [=](int j) { return n0 + j; }); continue; }
        r -= I_AB;
        { const int kb = r / 64, n0 = (r % 64) * 32; transpose_item(p.in[11], 2048, 2048, WOT, n0, kb * 64, scr, lane, [=](int j) { return n0 + j; }); }
    }
    const float* x = p.in[0];
    for (size_t i = (size_t)blockIdx.x * NTHREADS + tx; i < (size_t)M_ * D_ / 8; i += (size_t)gridDim.x * NTHREADS) {
        const float4 a = *(const float4*)(x + i * 8), b = *(const float4*)(x + i * 8 + 4);
        uint4 o; o.x = pk2(a.x, a.y); o.y = pk2(a.z, a.w); o.z = pk2(b.x, b.y); o.w = pk2(b.z, b.w);
        *(uint4*)(XB + i * 8) = o;
    }
}

namespace att {
typedef short bf16x8 __attribute__((ext_vector_type(8)));
typedef short s16x4 __attribute__((ext_vector_type(4)));
typedef float f32x16 __attribute__((ext_vector_type(16)));
typedef float f32x4 __attribute__((ext_vector_type(4)));
typedef unsigned u32x4 __attribute__((ext_vector_type(4)));
constexpr int QBLK = 32, KVBLK = 64;
constexpr int SHM_V = 16384, SHM_K = 16384;
constexpr int L_V = 0, L_K = 2 * SHM_V, L_WS = 65536, L_CN = L_WS + 2048, L_LUT = L_CN + 2048, L_IMPH = L_LUT + 4096, L_IMP2 = L_IMPH + 4 * 64 * 33 * 4, L_SELM = L_IMP2 + 64 * 33 * 4, L_QW = L_SELM + 256, L_END = L_QW + 64;
static_assert(L_END <= 131072, "attention LDS map");
constexpr float THR = 8.f;
constexpr float NEGINF = -__builtin_inff();

#define KSWZ(row, colB) ((row) * 256 + ((colB) ^ (((row) & 7) << 4)))
#define SBAR() __builtin_amdgcn_sched_barrier(0)
__device__ __forceinline__ int v_st(int k, int c) { const int kk = (k & ~0xC) | ((k & 4) << 1) | ((k & 8) >> 1); return ((kk >> 3) * 4 + (c >> 5)) * 512 + ((kk & 7) * 32 + (c & 31)) * 2; }
__device__ __forceinline__ int v_rd_base(int lane) { return ((lane & 3) << 3) | (((lane >> 2) & 3) << 6) | (((lane >> 4) & 1) << 5) | (((lane >> 5) & 1) << 8); }
constexpr int v_rd_off(int d0, int ks, int half) { return d0 * 512 + ks * 4096 + half * 2048; }
__device__ __forceinline__ int crow(int r, int hi) { return (r & 3) + 8 * (r >> 2) + 4 * hi; }
__device__ __forceinline__ unsigned cvtpk(float lo, float hi) { unsigned r; asm volatile("v_cvt_pk_bf16_f32 %0, %1, %2" : "=v"(r) : "v"(lo), "v"(hi)); return r; }

__device__ __forceinline__ void partialSM(f32x16& p0, f32x16& p1, float& m_reg, float& mn, float& alpha) {
    float pmax = p0[0];
#pragma unroll
    for (int r = 1; r < 16; ++r) pmax = fmaxf(pmax, p0[r]);
#pragma unroll
    for (int r = 0; r < 16; ++r) pmax = fmaxf(pmax, p1[r]);
    { auto rr = __builtin_amdgcn_permlane32_swap(__float_as_uint(pmax), __float_as_uint(pmax), false, false);
      pmax = fmaxf(__uint_as_float(rr[0]), __uint_as_float(rr[1])); }
    constexpr float C2 = 1.4426950408889634f * SCALE;
    if (__builtin_expect(__all((pmax - m_reg) * SCALE <= THR), 1)) { mn = m_reg; alpha = 1.f; }
    else { mn = fmaxf(m_reg, pmax); alpha = __builtin_amdgcn_exp2f((m_reg - mn) * C2); m_reg = mn; }
    const float mnL = -mn * C2;
#pragma unroll
    for (int r = 0; r < 16; ++r) p0[r] = fmaf(p0[r], C2, mnL);
#pragma unroll
    for (int r = 0; r < 16; ++r) p1[r] = fmaf(p1[r], C2, mnL);
#pragma unroll
    for (int r = 0; r < 16; ++r) p0[r] = __builtin_amdgcn_exp2f(p0[r]);
}
#define PK4(P, B_, OUT) do { unsigned a0 = cvtpk(P[B_+0], P[B_+1]), a1 = cvtpk(P[B_+2], P[B_+3]);                          \
        unsigned b0 = cvtpk(P[B_+4], P[B_+5]), b1 = cvtpk(P[B_+6], P[B_+7]);                                             \
        auto r0 = __builtin_amdgcn_permlane32_swap(a0, b0, false, false); auto r1 = __builtin_amdgcn_permlane32_swap(a1, b1, false, false); \
        u32x4 w = {r0[0], r1[0], r0[1], r1[1]}; OUT = *reinterpret_cast<bf16x8*>(&w); } while (0)
__device__ __forceinline__ void finishSM(f32x16& p0, f32x16& p1, float alpha, float& l_reg, bf16x8& pa0, bf16x8& pa1, bf16x8& pa2, bf16x8& pa3) {
#pragma unroll
    for (int r = 0; r < 16; ++r) p1[r] = __builtin_amdgcn_exp2f(p1[r]);
    float ps = 0;
#pragma unroll
    for (int r = 0; r < 16; ++r) ps += p0[r];
#pragma unroll
    for (int r = 0; r < 16; ++r) ps += p1[r];
    { auto rr = __builtin_amdgcn_permlane32_swap(__float_as_uint(ps), __float_as_uint(ps), false, false);
      ps = __uint_as_float(rr[0]) + __uint_as_float(rr[1]); }
    l_reg = l_reg * alpha + ps;
    PK4(p0, 0, pa0); PK4(p0, 8, pa1); PK4(p1, 0, pa2); PK4(p1, 8, pa3);
}
template <int KB, bool BIAS>
__device__ __forceinline__ void qkt(f32x16& p0, f32x16& p1, const char* K_lds, const char* cnb, int r32, int hi, const bf16x8* qr, bool act) {
    if (!act) {
#pragma unroll
        for (int r = 0; r < 16; ++r) { p0[r] = NEGINF; p1[r] = NEGINF; }
        return; }
    if (BIAS) {
        const bf16x8 c0 = *reinterpret_cast<const bf16x8*>(cnb + KB * 1024 + r32 * 16);
        const bf16x8 c1 = *reinterpret_cast<const bf16x8*>(cnb + KB * 1024 + 512 + r32 * 16);
        const short one = hi ? (short)0 : (short)0x3F80;
        const bf16x8 q1 = {one, one, one, 0, 0, 0, 0, 0};
        p0 = __builtin_amdgcn_mfma_f32_32x32x16_bf16(c0, q1, p0, 0, 0, 0);
        p1 = __builtin_amdgcn_mfma_f32_32x32x16_bf16(c1, q1, p1, 0, 0, 0);
    }
    const char* kb[4];
#pragma unroll
    for (int dd = 0; dd < 4; ++dd) kb[dd] = K_lds + KB * SHM_K + KSWZ(r32, (dd * 16 + hi * 8) * 2);
#pragma unroll
    for (int d0 = 0; d0 < 8; ++d0) { const char* a = kb[d0 & 3] + (d0 >> 2) * 128;
        bf16x8 b0 = *reinterpret_cast<const bf16x8*>(a);
        bf16x8 b1 = *reinterpret_cast<const bf16x8*>(a + 32 * 256);
        p0 = __builtin_amdgcn_mfma_f32_32x32x16_bf16(b0, qr[d0], p0, 0, 0, 0);
        p1 = __builtin_amdgcn_mfma_f32_32x32x16_bf16(b1, qr[d0], p1, 0, 0, 0); }
}
template <int VB>
__device__ __forceinline__ void pv_tile(f32x16* o, int vb0, bf16x8 pa0, bf16x8 pa1, bf16x8 pa2, bf16x8 pa3, bool act) {
    if (!act) return;
#define TRRD(dst, off) asm volatile("ds_read_b64_tr_b16 %0, %1 offset:%2" : "=&v"(dst) : "v"(vb0), "i"(off) : "memory")
#define PV_D0(d0) do { s16x4 l0, l1, l2, l3, h0, h1, h2, h3; constexpr int b_ = VB * SHM_V + v_rd_off(d0, 0, 0); \
        TRRD(l0, b_); TRRD(h0, b_ + 2048); TRRD(l1, b_ + 4096); TRRD(h1, b_ + 6144); TRRD(l2, b_ + 8192); TRRD(h2, b_ + 10240); TRRD(l3, b_ + 12288); TRRD(h3, b_ + 14336); \
        asm volatile("s_waitcnt lgkmcnt(0)" ::: "memory"); SBAR();   \
        o[d0] = __builtin_amdgcn_mfma_f32_32x32x16_bf16(pa0, (bf16x8){l0[0], l0[1], l0[2], l0[3], h0[0], h0[1], h0[2], h0[3]}, o[d0], 0, 0, 0);   \
        o[d0] = __builtin_amdgcn_mfma_f32_32x32x16_bf16(pa1, (bf16x8){l1[0], l1[1], l1[2], l1[3], h1[0], h1[1], h1[2], h1[3]}, o[d0], 0, 0, 0);   \
        o[d0] = __builtin_amdgcn_mfma_f32_32x32x16_bf16(pa2, (bf16x8){l2[0], l2[1], l2[2], l2[3], h2[0], h2[1], h2[2], h2[3]}, o[d0], 0, 0, 0);   \
        o[d0] = __builtin_amdgcn_mfma_f32_32x32x16_bf16(pa3, (bf16x8){l3[0], l3[1], l3[2], l3[3], h3[0], h3[1], h3[2], h3[3]}, o[d0], 0, 0, 0); } while (0)
    PV_D0(0); PV_D0(1); PV_D0(2); PV_D0(3);
#undef PV_D0
#undef TRRD
}

__device__ __forceinline__ void init_lut(f32x16& p0, f32x16& p1, const float* lut, int dq1  ) {
#pragma unroll
    for (int r = 0; r < 16; ++r) { const int c = (r & 3) + 8 * (r >> 2);
        p0[r] = lut[min(max(dq1 - c, 0), 114)]; p1[r] = lut[min(max(dq1 - c - 32, 0), 114)]; }
}
__device__ __forceinline__ void init_lut_cmp(f32x16& p0, f32x16& p1, const float* lut, int dq1  ) {
#pragma unroll
    for (int r = 0; r < 16; ++r) { const int c = 16 * ((r & 3) + 8 * (r >> 2));
        p0[r] = lut[min(max(dq1 - c, 0), 114)]; p1[r] = lut[min(max(dq1 - c - 512, 0), 114)]; }
}
__device__ __forceinline__ void init_const(f32x16& p0, f32x16& p1, float v) {
#pragma unroll
    for (int r = 0; r < 16; ++r) { p0[r] = v; p1[r] = v; }
}
__device__ __forceinline__ void init_edge(f32x16& p0, f32x16& p1, int dq  , int W) {
#pragma unroll
    for (int r = 0; r < 16; ++r) { const int c = (r & 3) + 8 * (r >> 2);
        p0[r] = (dq - c) < W ? 0.f : NEGINF; p1[r] = (dq - c - 32) < W ? 0.f : NEGINF; }
}
__device__ __forceinline__ void init_causal(f32x16& p0, f32x16& p1, int dq  ) {
#pragma unroll
    for (int r = 0; r < 16; ++r) { const int c = (r & 3) + 8 * (r >> 2);
        p0[r] = (dq - c) < 0 ? NEGINF : 0.f; p1[r] = (dq - c - 32) < 0 ? NEGINF : 0.f; }
}

template <int MODE, int pitch>
__device__ __forceinline__ void attn_pass(int wv, const bf16_t* __restrict__ Kp, const bf16_t* __restrict__ Vp, const bf16_t* __restrict__ CNp, int j_lo, int NT,
                                          const bf16x8* qr, int tpos, int qlo, unsigned selbits, const float* lut, char* lds, f32x16* o, float& l_out) {
    const int tid_ = tid_fresh(wv);
    const int tid = tid_, wid = wv, lane = tid & 63, r32 = lane & 31, hi = lane >> 5;
    char* V_lds = lds + L_V; char* K_lds = lds + L_K;
    float* ws = (float*)(lds + L_WS) + wid * 64; float* al_l = ws + 32;
    char* cnb = lds + L_CN;
    const int sr = tid >> 4, sc = (tid & 15) * 8, vst0 = v_st(sr, sc), vst1 = v_st(32 + sr, sc), kws = KSWZ(sr, sc * 2);
    const int vb0 = (int)(uintptr_t)V_lds + v_rd_base(lane);
    float m_reg = -1e30f, l_reg = 0.f;
#pragma unroll
    for (int d = 0; d < 4; ++d) o[d] = f32x16{};
    bf16x8 st_v0, st_v1, st_k0, st_k1, st_cn;
#define KBASE(t) ((j_lo + (t)) * KVBLK)
#define ROWP(p, k0, rr) ((p) + (size_t)((k0) + (rr)) * pitch + sc)
#define VMW() asm volatile("s_waitcnt vmcnt(0)" ::: "memory")
#define SLOAD(t) do { const int k0_ = KBASE(t); st_v0 = *(const bf16x8*)ROWP(Vp, k0_, sr); st_v1 = *(const bf16x8*)ROWP(Vp, k0_, 32 + sr);              \
                      st_k0 = *(const bf16x8*)ROWP(Kp, k0_, sr); st_k1 = *(const bf16x8*)ROWP(Kp, k0_, 32 + sr);                                          \
                      if (MODE == 0) { if (tid < 64) st_cn = *(const bf16x8*)(CNp + (size_t)(k0_ + tid) * 8); } } while (0)
#define SWRITE(bf) do { *(bf16x8*)(V_lds + (bf) * SHM_V + vst0) = st_v0; *(bf16x8*)(V_lds + (bf) * SHM_V + vst1) = st_v1;                                 \
                        *(bf16x8*)(K_lds + (bf) * SHM_K + kws) = st_k0; *(bf16x8*)(K_lds + (bf) * SHM_K + kws + 32 * 256) = st_k1;                        \
                        if (MODE == 0) { if (tid < 64) *(bf16x8*)(cnb + (bf) * 1024 + tid * 16) = st_cn; } } while (0)
#define RESC(a) do { if (__any((a) < 1.f)) { if (hi == 0) al_l[r32] = (a); asm volatile("s_waitcnt lgkmcnt(0)" ::: "memory");              \
                     _Pragma("unroll") for (int d_ = 0; d_ < 4; ++d_) _Pragma("unroll") for (int r = 0; r < 16; ++r) o[d_][r] *= al_l[crow(r, hi)]; } } while (0)
#define SELB(t) ((selbits >> (j_lo + (t))) & 1u)
#define ACT(t) (MODE == 2 ? (bool)__any(SELB(t)) : (MODE == 3 ? true : (KBASE(t) <= qlo + QBLK - 1)))
#define INIT(P0, P1, t, KB) do { const int kb_ = KBASE(t);                                                                                   \
        if (MODE == 0) { if (kb_ + KVBLK - 1 > qlo) init_causal(P0, P1, tpos - kb_ - 4 * hi); else init_const(P0, P1, 0.f); }                     \
        else { const bool near_ = kb_ + KVBLK - 1 > qlo - 113;                                                                                \
               if (near_) init_lut(P0, P1, lut, tpos - kb_ - 4 * hi + 1);                                                                    \
               else if (MODE == 3 && kb_ <= qlo + QBLK - 1 - 512) init_edge(P0, P1, tpos - kb_ - 4 * hi, 512);                                \
               else init_const(P0, P1, 0.f);                                                                                                 \
               if (MODE == 2) { if (!SELB(t)) init_const(P0, P1, NEGINF); } } } while (0)
    f32x16 p0, p1; float mn, al; bf16x8 pa0, pa1, pa2, pa3;
    SLOAD(0);
    __syncthreads();
    VMW(); SWRITE(0);
    __syncthreads();
#define STEP(t, BUF) do {                                                                                                     \
        if ((t) + 1 < NT) { SLOAD((t) + 1); }                                                                                  \
        SBAR(); INIT(p0, p1, t, BUF); qkt<BUF, MODE == 0>(p0, p1, K_lds, cnb, r32, hi, qr, ACT(t));                            \
        partialSM(p0, p1, m_reg, mn, al); RESC(al);                                                                            \
        finishSM(p0, p1, al, l_reg, pa0, pa1, pa2, pa3); SBAR();                                                               \
        pv_tile<BUF>(o, vb0, pa0, pa1, pa2, pa3, ACT(t));                                                                      \
        if ((t) + 1 < NT) { VMW(); SWRITE((BUF) ^ 1); }                                                                        \
        __syncthreads(); } while (0)
    int t = 0;
    for (; t + 1 < NT; t += 2) { STEP(t, 0); STEP(t + 1, 1); }
    if (t < NT) STEP(t, 0);
#undef STEP
    l_out = l_reg;
#undef KBASE
#undef ROWP
#undef SLOAD
#undef SWRITE
#undef RESC
#undef SELB
#undef ACT
#undef INIT
}

__device__ __forceinline__ void store_rows(const f32x16* o, const float* rs, bf16_t* stg, bf16_t* Orow0, size_t opitch, const bf16_t* Zrow0, size_t zpitch, int lane) {
    asm volatile("" : "+v"(lane));
    const int r32 = lane & 31, hi = lane >> 5;
#pragma unroll
    for (int r = 0; r < 16; ++r) { const int orow = crow(r, hi); const float s = rs[orow];
#pragma unroll
        for (int d0 = 0; d0 < 4; ++d0) stg[orow * 128 + d0 * 32 + r32] = f2bf(o[d0][r] * s); }
    asm volatile("s_waitcnt lgkmcnt(0)" ::: "memory");
#pragma unroll
    for (int i = 0; i < 8; ++i) { const int row = i * 4 + (lane >> 4), ch = lane & 15;
        const u32x4 v = *(const u32x4*)(stg + row * 128 + ch * 8);
        const u32x4 z = *(const u32x4*)(Zrow0 + (size_t)row * zpitch + ch * 8);
        u32x4 w;
#pragma unroll
        for (int e = 0; e < 4; ++e) { const float a = __uint_as_float(v[e] << 16) * __uint_as_float(z[e] << 16), b = __uint_as_float(v[e] & 0xffff0000u) * __uint_as_float(z[e] & 0xffff0000u); w[e] = cvtpk(a, b); }
        *(u32x4*)(Orow0 + (size_t)row * opitch + ch * 8) = w; }
}

__device__ __forceinline__ void fox_unit(int wv, int b, int h, int qb, const bf16_t* __restrict__ HB, const bf16_t* __restrict__ CNB, bf16_t* __restrict__ OA, char* lds) {
    const int tid = tid_fresh(wv), wid = wv, lane = tid & 63, r32 = lane & 31, hi = lane >> 5;
    const int q0 = qb * 256, qlo = q0 + wid * QBLK, tpos = qlo + r32;
    const bf16_t* Qrow = HB + (size_t)(b * S_ + tpos) * PITCH + H_FQ + h * 128;
    bf16x8 qr[8];
#pragma unroll
    for (int d0 = 0; d0 < 8; ++d0) qr[d0] = *(const bf16x8*)(Qrow + d0 * 16 + hi * 8);
    const bf16_t* Kp = HB + (size_t)(b * S_) * PITCH + H_FK + h * 128;
    const bf16_t* Vp = HB + (size_t)(b * S_) * PITCH + H_FV + h * 128;
    f32x16 o[4]; float l_reg;
    attn_pass<0, PITCH>(wv, Kp, Vp, CNB + (size_t)(b * 8 + h) * S_ * 8, 0, 4 * qb + 4, qr, tpos, qlo, 0u, nullptr, lds, o, l_reg);
    float* ws = (float*)(lds + L_WS) + wid * 64;
    if (hi == 0) ws[r32] = __builtin_amdgcn_rcpf(l_reg);
    __syncthreads();
    store_rows(o, ws, (bf16_t*)(lds + wid * 8192), OA + (size_t)(b * S_ + qlo) * 1024 + h * 128, 1024, HB + (size_t)(b * S_ + qlo) * PITCH + H_FZ + h * 128, PITCH, lane);
}

__device__ __forceinline__ void scale_rows(f32x16* o, float* wsw, float rowscale, int r32, int hi) {
    if (hi == 0) wsw[r32] = rowscale;
    asm volatile("s_waitcnt lgkmcnt(0)" ::: "memory");
#pragma unroll
    for (int r = 0; r < 16; ++r) { const float sc = wsw[crow(r, hi)];
#pragma unroll
        for (int d = 0; d < 4; ++d) o[d][r] *= sc; }
    asm volatile("s_waitcnt lgkmcnt(0)" ::: "memory");
}
__device__ __forceinline__ void scr_store(const f32x16* o, float* scr, int tid) {
#pragma unroll
    for (int d = 0; d < 4; ++d)
#pragma unroll
        for (int q = 0; q < 4; ++q) *(f32x4*)(scr + (size_t)((d * 4 + q) * 512 + tid) * 4) = (f32x4){o[d][4 * q], o[d][4 * q + 1], o[d][4 * q + 2], o[d][4 * q + 3]};
}
__device__ __forceinline__ void scr_add(f32x16* o, const float* scr, int tid) {
#pragma unroll
    for (int d = 0; d < 4; ++d)
#pragma unroll
        for (int q = 0; q < 4; ++q) { const f32x4 v = *(const f32x4*)(scr + (size_t)((d * 4 + q) * 512 + tid) * 4);
#pragma unroll
            for (int e = 0; e < 4; ++e) o[d][4 * q + e] += v[e]; }
}

__device__ __forceinline__ void nsa_unit(int wv, int b, int g, int cur, const bf16_t* __restrict__ HB, const bf16_t* __restrict__ KCMP, const bf16_t* __restrict__ VCMP,
                                         const float* __restrict__ NGATE, float* __restrict__ scr, bf16_t* __restrict__ OB, char* lds) {
    const int tid_ = tid_fresh(wv);
    const int tid = tid_, wid = wv, lane = tid & 63, r32 = lane & 31, hi = lane >> 5;
    const int hp = wid >> 1, head = g * 4 + hp, qrow = (wid & 1) * 32 + r32, qlo = 64 * cur + (wid & 1) * 32, tpos = qlo + r32;
    const size_t trow = (size_t)(b * S_ + tpos);
    float* wsw = (float*)(lds + L_WS) + wid * 64;
    const float* lut = (const float*)(lds + L_LUT) + head * 128;
    bf16x8 qr[8];
    { const bf16_t* Qrow = HB + trow * PITCH + H_NQ + head * 128;
#pragma unroll
      for (int d0 = 0; d0 < 8; ++d0) qr[d0] = *(const bf16x8*)(Qrow + d0 * 16 + hi * 8); }
    f32x16 o[4];
    unsigned selbits;
    {
        char* V_lds = lds + L_V; char* K_lds = lds + L_K;
        const bool two = 64 * cur + 63 >= 1055;
        const int sr = tid >> 4, sc = (tid & 15) * 8;
        const bf16_t* Kc = KCMP + (size_t)(b * 2 + g) * 128 * 128; const bf16_t* Vc = VCMP + (size_t)(b * 2 + g) * 128 * 128;
        bf16x8 k0 = *(const bf16x8*)(Kc + (size_t)sr * 128 + sc), k1 = *(const bf16x8*)(Kc + (size_t)(32 + sr) * 128 + sc);
        bf16x8 v0 = *(const bf16x8*)(Vc + (size_t)sr * 128 + sc), v1 = *(const bf16x8*)(Vc + (size_t)(32 + sr) * 128 + sc);
        bf16x8 k2 = k0, k3 = k1, v2 = v0, v3 = v1;
        if (two) { k2 = *(const bf16x8*)(Kc + (size_t)(64 + sr) * 128 + sc); k3 = *(const bf16x8*)(Kc + (size_t)(96 + sr) * 128 + sc);
                   v2 = *(const bf16x8*)(Vc + (size_t)(64 + sr) * 128 + sc); v3 = *(const bf16x8*)(Vc + (size_t)(96 + sr) * 128 + sc); }
        __syncthreads();
        { const int vst0 = v_st(sr, sc), vst1 = v_st(32 + sr, sc), kws = KSWZ(sr, sc * 2);
          *(bf16x8*)(V_lds + vst0) = v0; *(bf16x8*)(V_lds + vst1) = v1; *(bf16x8*)(K_lds + kws) = k0; *(bf16x8*)(K_lds + kws + 32 * 256) = k1;
          if (two) { *(bf16x8*)(V_lds + SHM_V + vst0) = v2; *(bf16x8*)(V_lds + SHM_V + vst1) = v3; *(bf16x8*)(K_lds + SHM_K + kws) = k2; *(bf16x8*)(K_lds + SHM_K + kws + 32 * 256) = k3; } }
        __syncthreads();
        f32x16 pA0, pA1, pB0, pB1;
        init_lut_cmp(pA0, pA1, lut, tpos - 31 - 64 * hi + 1);
        qkt<0, false>(pA0, pA1, K_lds, nullptr, r32, hi, qr, true);
        if (two) { init_lut_cmp(pB0, pB1, lut, tpos - 31 - 16 * 64 - 64 * hi + 1); qkt<1, false>(pB0, pB1, K_lds, nullptr, r32, hi, qr, true); }
        else init_const(pB0, pB1, NEGINF);
        float mx = -1e30f;
#pragma unroll
        for (int r = 0; r < 16; ++r) mx = fmaxf(fmaxf(mx, pA0[r]), fmaxf(pA1[r], fmaxf(pB0[r], pB1[r])));
        { auto rr = __builtin_amdgcn_permlane32_swap(__float_as_uint(mx), __float_as_uint(mx), false, false); mx = fmaxf(__uint_as_float(rr[0]), __uint_as_float(rr[1])); }
        constexpr float C2 = 1.4426950408889634f * SCALE;
        const float mL = -mx * C2; float ps = 0.f;
#pragma unroll
        for (int r = 0; r < 16; ++r) { pA0[r] = __builtin_amdgcn_exp2f(fmaf(pA0[r], C2, mL)); pA1[r] = __builtin_amdgcn_exp2f(fmaf(pA1[r], C2, mL));
                                       pB0[r] = __builtin_amdgcn_exp2f(fmaf(pB0[r], C2, mL)); pB1[r] = __builtin_amdgcn_exp2f(fmaf(pB1[r], C2, mL));
                                       ps += (pA0[r] + pA1[r]) + (pB0[r] + pB1[r]); }
        { auto rr = __builtin_amdgcn_permlane32_swap(__float_as_uint(ps), __float_as_uint(ps), false, false); ps = __uint_as_float(rr[0]) + __uint_as_float(rr[1]); }
        const float inv = ps > 0.f ? 1.f / ps : 0.f;
#pragma unroll
        for (int r = 0; r < 16; ++r) { pA0[r] *= inv; pA1[r] *= inv; pB0[r] *= inv; pB1[r] *= inv; }
        if (cur >= 8) {
            float* imph = (float*)(lds + L_IMPH) + (size_t)(hp * 64 + qrow) * 33;
            float up_prev = 0.f;
#define IMP_SLOTS(X, S0) do { _Pragma("unroll") for (int q = 0; q < 4; ++q) {                                                          \
                const float qs_ = (X[4 * q] + X[4 * q + 1]) + (X[4 * q + 2] + X[4 * q + 3]); const float le_ = X[4 * q + 3];            \
                auto rr = __builtin_amdgcn_permlane32_swap(__float_as_uint(le_), __float_as_uint(le_), false, false);                   \
                const float lo_ = __uint_as_float(rr[0]), up_ = __uint_as_float(rr[1]);                                               \
                imph[2 * ((S0) + q) + hi] = qs_ + (hi ? lo_ : up_prev); up_prev = up_; } } while (0)
            IMP_SLOTS(pA0, 0); IMP_SLOTS(pA1, 4); IMP_SLOTS(pB0, 8); IMP_SLOTS(pB1, 12);
#undef IMP_SLOTS
        }
        bf16x8 pa0, pa1, pa2, pa3;
#pragma unroll
        for (int d = 0; d < 4; ++d) o[d] = f32x16{};
        const int vb0 = (int)(uintptr_t)V_lds + v_rd_base(lane);
        PK4(pA0, 0, pa0); PK4(pA0, 8, pa1); PK4(pA1, 0, pa2); PK4(pA1, 8, pa3);
        pv_tile<0>(o, vb0, pa0, pa1, pa2, pa3, true);
        if (two) { PK4(pB0, 0, pa0); PK4(pB0, 8, pa1); PK4(pB1, 0, pa2); PK4(pB1, 8, pa3); pv_tile<1>(o, vb0, pa0, pa1, pa2, pa3, true); }
        scale_rows(o, wsw, NGATE[trow * 24 + head * 3 + 0], r32, hi);
        scr_store(o, scr, tid);
        if (cur >= 8) {
            __syncthreads();
            float* IH = (float*)(lds + L_IMPH); float* I2 = (float*)(lds + L_IMP2);
            for (int i = tid; i < 2048; i += 512) { const int q = i >> 5, j = i & 31;
                I2[q * 33 + j] = ((IH[(0 * 64 + q) * 33 + j] + IH[(1 * 64 + q) * 33 + j]) + IH[(2 * 64 + q) * 33 + j]) + IH[(3 * 64 + q) * 33 + j]; }
            __syncthreads();
            if (wid == 0) {
                unsigned chosen = 1u | (1u << cur) | (1u << (cur - 1));
                for (int k = 0; k < 5; ++k) { float bv = -1.f; int bj = 0;
                    for (int j = 1; j <= cur - 2; ++j) { const float v = I2[lane * 33 + j]; if (!((chosen >> j) & 1u) && v > bv) { bv = v; bj = j; } }
                    chosen |= 1u << bj; }
                ((unsigned*)(lds + L_SELM))[lane] = chosen;
            }
            __syncthreads();
            selbits = ((const unsigned*)(lds + L_SELM))[qrow];
        } else selbits = (1u << (cur + 1)) - 1u;
    }
    float l_reg;
    attn_pass<2, PITCH>(wv, HB + (size_t)(b * S_) * PITCH + H_KS + g * 128, HB + (size_t)(b * S_) * PITCH + H_VS + g * 128, nullptr, 0, cur + 1, qr, tpos, qlo, selbits, lut, lds, o, l_reg);
    scale_rows(o, wsw, NGATE[(size_t)(b * S_ + tpos) * 24 + head * 3 + 1] * __builtin_amdgcn_rcpf(l_reg), r32, hi);
    scr_add(o, scr, tid);
    scr_store(o, scr, tid);
    { const int jl = cur >= 8 ? cur - 8 : 0;
      attn_pass<3, PITCH>(wv, HB + (size_t)(b * S_) * PITCH + H_KW + g * 128, HB + (size_t)(b * S_) * PITCH + H_VW + g * 128, nullptr, jl, cur + 1 - jl, qr, tpos, qlo, 0u, lut, lds, o, l_reg); }
    scale_rows(o, wsw, NGATE[(size_t)(b * S_ + tpos) * 24 + head * 3 + 2] * __builtin_amdgcn_rcpf(l_reg), r32, hi);
    scr_add(o, scr, tid);
    if (hi == 0) wsw[r32] = 1.f;
    __syncthreads();
    store_rows(o, wsw, (bf16_t*)(lds + wid * 8192), OB + (size_t)(b * S_ + qlo) * 1024 + head * 128, 1024, HB + (size_t)(b * S_ + qlo) * PITCH + H_NZ + head * 128, PITCH, lane);
}
__device__ __forceinline__ void build_lut(int wv, const float* __restrict__ rel_bias, char* lds) {
    float* L = (float*)(lds + L_LUT);
    for (int i = tid_fresh(wv); i < 1024; i += NTHREADS) { const int h = i >> 7, k = i & 127;
        L[i] = k == 0 ? NEGINF : (k <= 113 ? (rel_bias[rel_bucket(k - 1) * 8 + h] - rel_bias[31 * 8 + h]) * 11.313708498984761f : 0.f); }
    __syncthreads();
}

__device__ const unsigned short UNIT_ORDER[512] = {31,63,95,127,159,191,223,255,30,62,94,126,158,190,222,254,29,61,93,125,157,189,221,253,28,60,92,124,156,188,220,252,27,59,91,123,155,187,219,251,26,58,90,122,154,186,218,250,25,57,89,121,153,185,217,249,24,56,88,120,152,184,216,248,23,55,87,119,151,183,215,247,22,54,86,118,150,182,214,246,21,53,85,117,149,181,213,245,20,52,84,116,148,180,212,244,32775,32783,32791,32799,32807,32815,32823,32831,19,51,32839,32847,32855,32863,32871,32879,32887,32895,83,115,32903,32911,32919,32927,32935,32943,32951,32959,147,179,32967,32975,32983,32991,32999,33007,33015,33023,211,243,18,50,82,114,146,178,210,242,17,49,81,113,145,177,209,241,16,48,80,112,144,176,208,240,32774,32782,32790,32798,32806,32814,32822,32830,15,47,32838,32846,32854,32862,32870,32878,32886,32894,79,111,32902,32910,32918,32926,32934,32942,32950,32958,143,175,32966,32974,32982,32990,32998,33006,33014,33022,207,239,14,46,78,110,142,174,206,238,13,45,77,109,141,173,205,237,12,44,76,108,140,172,204,236,32773,32781,32789,32797,32805,32813,32821,32829,11,43,32837,32845,32853,32861,32869,32877,32885,32893,75,107,32901,32909,32917,32925,32933,32941,32949,32957,139,171,32965,32973,32981,32989,32997,33005,33013,33021,203,235,10,42,74,106,138,170,202,234,9,41,73,105,137,169,201,233,8,40,72,104,136,168,200,232,32772,32780,32788,32796,32804,32812,32820,32828,32836,32844,32852,32860,32868,32876,32884,32892,32900,32908,32916,32924,32932,32940,32948,32956,32964,32972,32980,32988,32996,33004,33012,33020,7,39,71,103,135,167,199,231,6,38,70,102,134,166,198,230,32771,32779,32787,32795,32803,32811,32819,32827,32835,32843,32851,32859,32867,32875,32883,32891,32899,32907,32915,32923,32931,32939,32947,32955,32963,32971,32979,32987,32995,33003,33011,33019,5,37,69,101,133,165,197,229,4,36,68,100,132,164,196,228,32770,32778,32786,32794,32802,32810,32818,32826,32834,32842,32850,32858,32866,32874,32882,32890,32898,32906,32914,32922,32930,32938,32946,32954,32962,32970,32978,32986,32994,33002,33010,33018,3,35,67,99,131,163,195,227,2,34,66,98,130,162,194,226,32769,32777,32785,32793,32801,32809,32817,32825,32833,32841,32849,32857,32865,32873,32881,32889,32897,32905,32913,32921,32929,32937,32945,32953,32961,32969,32977,32985,32993,33001,33009,33017,1,33,65,97,129,161,193,225,0,32,64,96,128,160,192,224,32768,32776,32784,32792,32800,32808,32816,32824,32832,32840,32848,32856,32864,32872,32880,32888,32896,32904,32912,32920,32928,32936,32944,32952,32960,32968,32976,32984,32992,33000,33008,33016};
__device__ __forceinline__ void attn_phase(int wv, const bf16_t* __restrict__ HB, const bf16_t* __restrict__ CNB, const bf16_t* __restrict__ KCMP, const bf16_t* __restrict__ VCMP,
                                           const float* __restrict__ NGATE, const float* __restrict__ rel_bias, float* __restrict__ scr, bf16_t* __restrict__ OA, bf16_t* __restrict__ OB,
                                           unsigned* __restrict__ qctr, char* lds) {
    build_lut(wv, rel_bias, lds);
    volatile unsigned* qw = (volatile unsigned*)(lds + L_QW);
    for (;;) {
        if (tid_fresh(wv) == 0) qw[0] = atomicAdd(qctr, 1u);
        __syncthreads();
        const unsigned i = qw[0];
        __syncthreads();
        if (i >= 512u) break;
        const unsigned u = UNIT_ORDER[i];
        if (u & 0x8000u) fox_unit(wv, (int)((u >> 6) & 3u), (int)((u >> 3) & 7u), (int)(u & 7u), HB, CNB, OA, lds);
        else nsa_unit(wv, (int)((u >> 6) & 3u), (int)((u >> 5) & 1u), (int)(u & 31u), HB, KCMP, VCMP, NGATE, scr, OB, lds);
    }
}
#undef KSWZ
#undef SBAR
#undef PK4
#undef VMW
}

__global__ void __launch_bounds__(NTHREADS, 2) fwd_megakernel(Params p) {
    extern __shared__ __attribute__((aligned(16))) unsigned char lds[];
    cg::grid_group grid = cg::this_grid();
    const int wv = __builtin_amdgcn_readfirstlane(threadIdx.x >> 6);
    PG8_LAS unsigned char* ldsl = (PG8_LAS unsigned char*)lds;
#define WSP(name) unsigned char* name = p.ws; asm volatile("" : "+s"(name))
    { WSP(ws); p0_phase(wv, p, (bf16_t*)(ws + WS_XB), (bf16_t*)(ws + WS_WINT), (bf16_t*)(ws + WS_WABT), (bf16_t*)(ws + WS_WOT), lds); }
    grid.sync();
    { WSP(ws); pg8::Gemm g{(bf16_t*)(ws + WS_XB), (bf16_t*)(ws + WS_WINT), M_, 12032, 2048}; pg8::StaticOrder S; S.init(M_, 12032, (int)gridDim.x, (int)blockIdx.x);
      pg8::EpiH1 E{(bf16_t*)(ws + WS_HB), (float*)(ws + WS_LOGF), (float*)(ws + WS_NGATE), p.in[2]};
      pg8::gemm_phase<pg8::EpiH1, pg8::StaticOrder, true, true>(wv, ldsl, g, S, E); }
    grid.sync();
    { WSP(ws); cumsum_phase(wv, (float*)(ws + WS_LOGF), (bf16_t*)(ws + WS_CN));
      compress_naive_phase(wv, (bf16_t*)(ws + WS_HB), p.in, (bf16_t*)(ws + WS_KCMP), (bf16_t*)(ws + WS_VCMP), lds); }
    grid.sync();
    { WSP(ws); att::attn_phase(wv, (bf16_t*)(ws + WS_HB), (bf16_t*)(ws + WS_CN), (bf16_t*)(ws + WS_KCMP), (bf16_t*)(ws + WS_VCMP), (float*)(ws + WS_NGATE), p.in[14],
                      (float*)(ws + WS_T1B) + (size_t)blockIdx.x * 32768, (bf16_t*)(ws + WS_OA), (bf16_t*)(ws + WS_OB), (unsigned*)(ws + WS_CTL) + 64, (char*)lds); }
    grid.sync();
    { WSP(ws); pg8::Gemm g{(bf16_t*)(ws + WS_OA), (bf16_t*)(ws + WS_WABT), 2 * M_, 4096, 1024}; pg8::PairOrder S{(int)gridDim.x, (int)blockIdx.x};
      pg8::EpiMerge E{(bf16_t*)(ws + WS_HB), (pg8::u32x4*)(ws + WS_T1B), (bf16_t*)(ws + WS_MRG)};
      pg8::gemm_phase<pg8::EpiMerge, pg8::PairOrder, true, true>(wv, ldsl, g, S, E); }
    grid.sync();
    { WSP(ws); pg8::Gemm g{(bf16_t*)(ws + WS_MRG), (bf16_t*)(ws + WS_WOT), M_, 2048, 2048}; pg8::StaticOrder S; S.init(M_, 2048, (int)gridDim.x, (int)blockIdx.x);
      pg8::EpiRes5 E{p.in[0], p.out};
      pg8::gemm_phase<pg8::EpiRes5, pg8::StaticOrder, true, true>(wv, ldsl, g, S, E); }
    grid.sync();
    ln_phase(wv, p.out, p.in[12], p.in[13], lds);
#undef WSP
}
}

extern "C" void kernel_launch(void* const* d_in, const int* in_sizes, int n_in, void* d_out, int out_size, void* d_ws, size_t ws_size, hipStream_t stream) {
    static int grid_blocks = 0;
    if (grid_blocks == 0) {
        if (n_in != 15 || ws_size < WS_END || out_size != M_ * D_) { fprintf(stderr, "kernel_launch: unexpected shapes/ws (%d inputs, ws %zu, out %d)\n", n_in, ws_size, out_size); grid_blocks = -1; return; }
        int dev = 0, cus = 0, per_cu = 0;
        (void)hipGetDevice(&dev);
        (void)hipDeviceGetAttribute(&cus, hipDeviceAttributeMultiprocessorCount, dev);
        if (hipFuncSetAttribute((const void*)fwd_megakernel, hipFuncAttributeMaxDynamicSharedMemorySize, LDS_BYTES) != hipSuccess) { fprintf(stderr, "kernel_launch: hipFuncSetAttribute failed\n"); grid_blocks = -1; return; }
        (void)hipOccupancyMaxActiveBlocksPerMultiprocessor(&per_cu, (const void*)fwd_megakernel, NTHREADS, LDS_BYTES);
        if (per_cu < 1) { fprintf(stderr, "kernel_launch: occupancy query says %d blocks/CU\n", per_cu); grid_blocks = -1; return; }
        grid_blocks = cus;
        fprintf(stderr, "kernel_launch: %d CUs, occupancy %d/CU, grid %d, ws %zu\n", cus, per_cu, grid_blocks, ws_size);
    }
    if (grid_blocks < 0) return;
    (void)hipMemsetAsync((char*)d_ws + WS_CTL, 0, 65536, stream);
    Params p{};
    for (int i = 0; i < 15; ++i) p.in[i] = (const float*)d_in[i];
    p.out = (float*)d_out; p.ws = (unsigned char*)d_ws;
    void* args[] = {&p};
    hipError_t e = hipLaunchCooperativeKernel((const void*)fwd_megakernel, dim3(grid_blocks), dim3(NTHREADS), args, LDS_BYTES, stream);
    if (e != hipSuccess) fprintf(stderr, "cooperative launch failed: %s (grid %d)\n", hipGetErrorString(e), grid_blocks);
}
```

```cpp
#include <hip/hip_runtime.h>
#include <cstdio>
#include <cstdint>

namespace {
constexpr int B_ = 4, S_ = 2048, D_ = 2048, M_ = B_ * S_;
constexpr int INC = 11808;
constexpr int NCMP = 127;
constexpr float SCALE = 0.08838834764831845f;
constexpr float ALPHA = 1.189207115002721f;
constexpr int PITCH = 11776;
constexpr int H_FQ = 0, H_FK = 1024, H_FV = 2048, H_FZ = 3072, H_NQ = 4096, H_KC = 5120, H_VC = 5376, H_KS = 5632, H_VS = 5888,
              H_KW = 6144, H_VW = 6400, H_NZ = 6656, H_GA = 7680, H_GB = 9728;
constexpr size_t MiB = 1u << 20;
constexpr size_t WS_CTL = 0;
constexpr size_t WS_HB = 1 * MiB;
constexpr size_t WS_CN = 185 * MiB;
constexpr size_t WS_LOGF = 186 * MiB;
constexpr size_t WS_NGATE = 187 * MiB;
constexpr size_t WS_CC = 188 * MiB;
constexpr size_t WS_KCMP = 189 * MiB;
constexpr size_t WS_VCMP = 190 * MiB;
constexpr size_t WS_SEL = 191 * MiB;
constexpr size_t WS_OA = 192 * MiB;
constexpr size_t WS_OB = 208 * MiB;
constexpr size_t WS_MRG = 224 * MiB;
constexpr size_t WS_PC = 256 * MiB;
constexpr size_t WS_OAF = 288 * MiB;
constexpr size_t WS_OBF = 320 * MiB;
constexpr size_t WS_XB = 256 * MiB;
constexpr size_t WS_WINT = 288 * MiB;
constexpr size_t WS_T1B = 256 * MiB;
constexpr size_t WS_WABT = 352 * MiB;
constexpr size_t WS_WOT = 360 * MiB;
constexpr size_t WS_W1T = 335 * MiB;
constexpr size_t WS_W2T = 339 * MiB;
constexpr size_t WS_POSW = 340 * MiB;
constexpr size_t WS_END = 368 * MiB;

constexpr int NTHREADS = 512;
constexpr int LDS_BYTES = 147456;

typedef unsigned short bf16_t;
__device__ __forceinline__ float bf2f(bf16_t v) { return __uint_as_float((unsigned)v << 16); }
__device__ __forceinline__ bf16_t f2bf(float f) { unsigned u = __float_as_uint(f); return (bf16_t)((u + 0x7fffu + ((u >> 16) & 1u)) >> 16); }

__device__ __forceinline__ int tid_fresh(int wv) { int t = wv * 64 + (int)__builtin_amdgcn_mbcnt_hi(~0u, __builtin_amdgcn_mbcnt_lo(~0u, 0u)); asm volatile("" : "+v"(t)); return t; }
__device__ __forceinline__ int rel_bucket(int n) {
    if (n < 16) return n < 0 ? 0 : n;
    int b = 16;
    b += n >= 19; b += n >= 21; b += n >= 24; b += n >= 27; b += n >= 31; b += n >= 35; b += n >= 40; b += n >= 46;
    b += n >= 52; b += n >= 59; b += n >= 67; b += n >= 77; b += n >= 87; b += n >= 99; b += n >= 113;
    return b;
}
__device__ __forceinline__ float sigmoidf_(float v) { return 1.f / (1.f + expf(-v)); }
__device__ __forceinline__ float siluf_(float v) { return v / (1.f + expf(-v)); }
__device__ __forceinline__ float log_sigmoidf_(float v) { return fminf(v, 0.f) - log1pf(expf(-fabsf(v))); }
__device__ __forceinline__ float gelu_tanh(float v) { return 0.5f * v * (1.f + tanhf(0.7978845608028654f * (v + 0.044715f * v * v * v))); }

struct Params { const float* in[15]; float* out; unsigned char* ws; };

template <class TA> __device__ __forceinline__ float4 ld4(const TA* p);
template <> __device__ __forceinline__ float4 ld4<float>(const float* p) { return *(const float4*)p; }
template <> __device__ __forceinline__ float4 ld4<bf16_t>(const bf16_t* p) { const uint2 u = *(const uint2*)p; return make_float4(__uint_as_float(u.x << 16), __uint_as_float(u.x & 0xffff0000u), __uint_as_float(u.y << 16), __uint_as_float(u.y & 0xffff0000u)); }

template <class TA, class Epi>
__device__ __forceinline__ void gemm_naive_phase(int wv, const TA* __restrict__ A, const float* __restrict__ Bm, int lda, int ldb, int Mr, int N, int K, const Epi& epi, unsigned char* lds) {
    const int tf = tid_fresh(wv); const int half = tf >> 8, tid = tf & 255, tx = tid & 15, ty = tid >> 4;
    float (*As)[68] = (float (*)[68])(lds + half * 8704);
    float (*Bs)[68] = (float (*)[68])(lds + half * 8704 + 4352);
    const int ntn = (N + 63) / 64, nvb = (Mr / 64) * ntn, stride = gridDim.x * 2;
    const int iters = (nvb + stride - 1) / stride;
    const int ar = tid >> 2, ac = (tid & 3) * 4, br = tid >> 4, bc = (tid & 15) * 4;
    for (int it = 0; it < iters; ++it) {
        const int vb = it * stride + blockIdx.x * 2 + half;
        const bool act = vb < nvb;
        const int m0 = act ? (vb / ntn) * 64 : 0, n0 = act ? (vb % ntn) * 64 : 0;
        float acc[4][4];
#pragma unroll
        for (int i = 0; i < 4; ++i)
#pragma unroll
            for (int j = 0; j < 4; ++j) acc[i][j] = 0.f;
        for (int k0 = 0; k0 < K; k0 += 16) {
            const float4 a = ld4<TA>(A + (size_t)(m0 + ar) * lda + k0 + ac);
            As[ac + 0][ar] = a.x; As[ac + 1][ar] = a.y; As[ac + 2][ar] = a.z; As[ac + 3][ar] = a.w;
            float4 b = make_float4(0.f, 0.f, 0.f, 0.f);
            if (n0 + bc < N) b = *(const float4*)(Bm + (size_t)(k0 + br) * ldb + n0 + bc);
            *(float4*)&Bs[br][bc] = b;
            __syncthreads();
#pragma unroll
            for (int kk = 0; kk < 16; ++kk) {
                const float4 av = *(const float4*)&As[kk][ty * 4];
                const float4 bv = *(const float4*)&Bs[kk][tx * 4];
                const float aa[4] = {av.x, av.y, av.z, av.w}, bb[4] = {bv.x, bv.y, bv.z, bv.w};
#pragma unroll
                for (int i = 0; i < 4; ++i)
#pragma unroll
                    for (int j = 0; j < 4; ++j) acc[i][j] += aa[i] * bb[j];
            }
            __syncthreads();
        }
        if (act) {
#pragma unroll
            for (int i = 0; i < 4; ++i)
#pragma unroll
                for (int j = 0; j < 4; ++j) { const int n = n0 + tx * 4 + j; if (n < N) epi(m0 + ty * 4 + i, n, acc[i][j]); }
        }
    }
}
struct EpiH {
    bf16_t* HB; float* LOGF; float* NGATE; const float* b_f;
    __device__ __forceinline__ void operator()(int m, int n, float a) const {
        if (n < 3072) HB[(size_t)m * PITCH + n] = f2bf(a);
        else if (n < 3080) LOGF[(size_t)m * 8 + (n - 3072)] = log_sigmoidf_(a + b_f[n - 3072]);
        else if (n < 4104) HB[(size_t)m * PITCH + n - 8] = f2bf(siluf_(a));
        else if (n < 6664) HB[(size_t)m * PITCH + n - 8] = f2bf(a);
        else if (n < 6688) NGATE[(size_t)m * 24 + (n - 6664)] = sigmoidf_(a);
        else if (n < 7712) HB[(size_t)m * PITCH + n - 32] = f2bf(siluf_(a));
        else HB[(size_t)m * PITCH + n - 32] = f2bf(sigmoidf_(a));
    }
};
struct EpiGateA { const bf16_t* HB; float* T1; __device__ __forceinline__ void operator()(int m, int n, float a) const { T1[(size_t)m * 2048 + n] = bf2f(HB[(size_t)m * PITCH + H_GA + n]) * a; } };
struct EpiGateB { const bf16_t* HB; const float* T1; bf16_t* MRG; __device__ __forceinline__ void operator()(int m, int n, float a) const { MRG[(size_t)m * 2048 + n] = f2bf(T1[(size_t)m * 2048 + n] + bf2f(HB[(size_t)m * PITCH + H_GB + n]) * a); } };
struct EpiRes { const float* X; float* O; __device__ __forceinline__ void operator()(int m, int n, float a) const { O[(size_t)m * D_ + n] = ALPHA * X[(size_t)m * D_ + n] + a; } };

__device__ __forceinline__ void cumsum_phase(int wv, const float* __restrict__ LOGF, bf16_t* __restrict__ CN) {
    const int tx = tid_fresh(wv); const int lane = tx & 63, gw = blockIdx.x * (NTHREADS / 64) + (tx >> 6);
    if (gw >= B_ * 8) return;
    const int b = gw >> 3, h = gw & 7;
    double run = 0.0;
    for (int i = 0; i < 32; ++i) run += (double)LOGF[(size_t)(b * S_ + lane * 32 + i) * 8 + h];
    double incl = run;
#pragma unroll
    for (int o = 1; o < 64; o <<= 1) { const double v = __shfl_up(incl, o); if (lane >= o) incl += v; }
    double base = incl - run;
    for (int i = 0; i < 32; ++i) { base += (double)LOGF[(size_t)(b * S_ + lane * 32 + i) * 8 + h];         { const float v = (float)(-base * 11.313708498984761); const bf16_t h0 = f2bf(v); const float r1 = v - bf2f(h0); const bf16_t h1 = f2bf(r1); const bf16_t h2 = f2bf(r1 - bf2f(h1));
          uint4 w; w.x = (unsigned)h0 | ((unsigned)h1 << 16); w.y = (unsigned)h2; w.z = 0u; w.w = 0u; *(uint4*)(CN + ((size_t)gw * S_ + lane * 32 + i) * 8) = w; } }
}

__device__ __forceinline__ void ln_phase(int wv, float* __restrict__ X, const float* __restrict__ g, const float* __restrict__ bta, unsigned char* lds) {
    const int tx = tid_fresh(wv); const int half = tx >> 8, tid = tx & 255;
    float* red = (float*)(lds + half * 1024);
    for (int r0 = blockIdx.x * 2; r0 < M_; r0 += gridDim.x * 2) {
        float* xr = X + (size_t)(r0 + half) * D_;
        float v[8]; float s = 0.f;
#pragma unroll
        for (int i = 0; i < 8; ++i) { v[i] = xr[tid + 256 * i]; s += v[i]; }
        red[tid] = s; __syncthreads();
        for (int o = 128; o > 0; o >>= 1) { if (tid < o) red[tid] += red[tid + o]; __syncthreads(); }
        const float mean = red[0] * (1.f / D_); __syncthreads();
        float q = 0.f;
#pragma unroll
        for (int i = 0; i < 8; ++i) { v[i] -= mean; q += v[i] * v[i]; }
        red[tid] = q; __syncthreads();
        for (int o = 128; o > 0; o >>= 1) { if (tid < o) red[tid] += red[tid + o]; __syncthreads(); }
        const float rstd = rsqrtf(red[0] * (1.f / D_) + 1e-5f);
        __syncthreads();
#pragma unroll
        for (int i = 0; i < 8; ++i) xr[tid + 256 * i] = v[i] * rstd * g[tid + 256 * i] + bta[tid + 256 * i];
    }
}


namespace pg8 {
#define PG8_LAS __attribute__((address_space(3)))
typedef unsigned short bf16_t;
typedef short bf16x8 __attribute__((ext_vector_type(8)));
typedef float f32x4 __attribute__((ext_vector_type(4)));
typedef unsigned u32x4 __attribute__((ext_vector_type(4)));
constexpr int BM = 256, BK = 64, HALF = 128, HTB = HALF * BK * 2  , STAGE_BYTES = 8 * HTB, NXCD = 8, WGM = 8;

__host__ __device__ __forceinline__ int lds_byte(int r, int c) { const int st = (r >> 4) * 2 + (c >> 5), rr = r & 15, cc = c & 31, ob = rr * 64 + cc * 2; return st * 1024 + (ob ^ (((ob >> 9) & 1) << 5)); }
__host__ __device__ __forceinline__ void stage_rc(int b, int& R, int& C) { const int st = b / 1024, sb = b % 1024, swz = sb ^ (((sb >> 9) & 1) << 5); R = (st >> 1) * 16 + swz / 64; C = (st & 1) * 32 + (swz % 64) / 2; }
__host__ __device__ __forceinline__ int perm32(int rho) { const int n = rho >> 4, i = rho & 15; return 8 * (i >> 2) + 4 * n + (i & 3); }

struct Unit { int pm, pn; };
struct Gemm { const bf16_t* A; const bf16_t* Bt; int M, N, K; };

struct StaticOrder {
    int nM, nN, nwg, G, c;
    __host__ __device__ void init(int M, int N, int G_, int c_) { nM = M / BM; nN = N / BM; nwg = nM * nN; G = G_; c = c_; }
    __host__ __device__ bool next(int i, Unit& u) const {
        const long L = (long)i * G + c; if (L >= nwg) return false;
        int wgid = (int)L; { const int q = nwg / NXCD, r = nwg % NXCD, xcd = wgid % NXCD, off = wgid / NXCD; wgid = (xcd < r ? xcd * (q + 1) : r * (q + 1) + (xcd - r) * q) + off; }
        const int nig = WGM * nN, gid = wgid / nig, fm = gid * WGM, gsz = (nM - fm) < WGM ? (nM - fm) : WGM;
        u.pm = fm + ((wgid % nig) % gsz); u.pn = (wgid % nig) / gsz; return true;
    }
    __device__ __forceinline__ void a_ready(const Unit&) const {}
    __device__ __forceinline__ void done(const Unit&) const {}
};

__device__ __forceinline__ unsigned cvt_pk_bf16(float lo, float hi) { unsigned r; asm volatile("v_cvt_pk_bf16_f32 %0, %1, %2" : "=v"(r) : "v"(lo), "v"(hi)); return r; }
__device__ __forceinline__ float fast_sigmoid(float v) { return __builtin_amdgcn_rcpf(1.f + __builtin_amdgcn_exp2f(-1.4426950408889634f * v)); }
__device__ __forceinline__ f32x4 act4(f32x4 v, int act) {
    if (act == 0) return v;
    f32x4 s; s[0] = fast_sigmoid(v[0]); s[1] = fast_sigmoid(v[1]); s[2] = fast_sigmoid(v[2]); s[3] = fast_sigmoid(v[3]);
    return act == 1 ? v * s : s;
}
struct EpiH1 {
    static constexpr bool PERM = true, AFTER_DRAIN = false;
    bf16_t* HB; float* LOGF; float* NGATE; const float* b_f;
    __device__ __forceinline__ void operator()(const f32x4 (&acc)[2][2][4][2], const Unit& u, int wr, int wc, int fr, int fq) const {
        const int row0 = u.pm * BM + wr * 64 + fr;
        if (u.pn < 46) {
            const int act = ((u.pn >= 12 && u.pn < 16) || (u.pn >= 26 && u.pn < 30)) ? 1 : (u.pn >= 30 ? 2 : 0);
            const int col0 = u.pn * BM + wc * 32 + 8 * fq;
#pragma unroll
            for (int ai = 0; ai < 2; ++ai)
#pragma unroll
                for (int m = 0; m < 4; ++m) { bf16_t* rowp = HB + (size_t)(row0 + ai * HALF + m * 16) * 11776 + col0;
#pragma unroll
                    for (int bj = 0; bj < 2; ++bj) { const f32x4 v0 = act4(acc[ai][bj][m][0], act), v1 = act4(acc[ai][bj][m][1], act);
                        u32x4 w; w.x = cvt_pk_bf16(v0[0], v0[1]); w.y = cvt_pk_bf16(v0[2], v0[3]); w.z = cvt_pk_bf16(v1[0], v1[1]); w.w = cvt_pk_bf16(v1[2], v1[3]);
                        *(u32x4*)(rowp + bj * HALF) = w; } }
        } else if (wc == 0) {
#pragma unroll
            for (int ai = 0; ai < 2; ++ai)
#pragma unroll
                for (int m = 0; m < 4; ++m) { const size_t row = (size_t)(row0 + ai * HALF + m * 16);
#pragma unroll
                    for (int n = 0; n < 2; ++n) { const f32x4 v = acc[ai][0][m][n];
                        if (fq == 0) { f32x4 o;
#pragma unroll
                            for (int e = 0; e < 4; ++e) { const float t = v[e] + b_f[4 * n + e]; o[e] = fminf(t, 0.f) - 0.6931471805599453f * __builtin_amdgcn_logf(1.f + __builtin_amdgcn_exp2f(-1.4426950408889634f * fabsf(t))); }
                            *(f32x4*)(LOGF + row * 8 + 4 * n) = o; }
                        else { f32x4 o;
#pragma unroll
                            for (int e = 0; e < 4; ++e) o[e] = fast_sigmoid(v[e]);
                            *(f32x4*)(NGATE + row * 24 + 8 * fq + 4 * n - 8) = o; } } }
        }
    }
};
struct EpiMerge {
    static constexpr bool PERM = true, AFTER_DRAIN = false;
    const bf16_t* HB; u32x4* T1; bf16_t* MRG;
    __device__ __forceinline__ void operator()(const f32x4 (&acc)[2][2][4][2], const Unit& u, int wr, int wc, int fr, int fq) const {
        const int pass = u.pm >> 5, pm = u.pm & 31, pn = u.pn & 7;
        const int row0 = pm * BM + wr * 64 + fr, col0 = pn * BM + wc * 32 + 8 * fq;
        u32x4* t1 = T1 + (size_t)(pm * 8 + pn) * (16 * 512) + (wr * 4 + wc) * 64 + fq * 16 + fr;
        const int gcol = (pass ? 9728 : 7680) + col0;
#pragma unroll
        for (int ai = 0; ai < 2; ++ai)
#pragma unroll
            for (int m = 0; m < 4; ++m) { const size_t row = (size_t)(row0 + ai * HALF + m * 16);
#pragma unroll
                for (int bj = 0; bj < 2; ++bj) {
                    const u32x4 gw = *(const u32x4*)(HB + row * 11776 + gcol + bj * HALF);
                    f32x4 g0, g1; g0[0] = __uint_as_float(gw.x << 16); g0[1] = __uint_as_float(gw.x & 0xffff0000u); g0[2] = __uint_as_float(gw.y << 16); g0[3] = __uint_as_float(gw.y & 0xffff0000u);
                    g1[0] = __uint_as_float(gw.z << 16); g1[1] = __uint_as_float(gw.z & 0xffff0000u); g1[2] = __uint_as_float(gw.w << 16); g1[3] = __uint_as_float(gw.w & 0xffff0000u);
                    f32x4 v0 = acc[ai][bj][m][0] * g0, v1 = acc[ai][bj][m][1] * g1;
                    u32x4* tp = t1 + (size_t)((ai * 4 + m) * 2 + bj) * 512;
                    if (pass) { const u32x4 tw = *tp;
                        v0[0] += __uint_as_float(tw.x << 16); v0[1] += __uint_as_float(tw.x & 0xffff0000u); v0[2] += __uint_as_float(tw.y << 16); v0[3] += __uint_as_float(tw.y & 0xffff0000u);
                        v1[0] += __uint_as_float(tw.z << 16); v1[1] += __uint_as_float(tw.z & 0xffff0000u); v1[2] += __uint_as_float(tw.w << 16); v1[3] += __uint_as_float(tw.w & 0xffff0000u); }
                    u32x4 w; w.x = cvt_pk_bf16(v0[0], v0[1]); w.y = cvt_pk_bf16(v0[2], v0[3]); w.z = cvt_pk_bf16(v1[0], v1[1]); w.w = cvt_pk_bf16(v1[2], v1[3]);
                    if (pass) *(u32x4*)(MRG + row * 2048 + col0 + bj * HALF) = w; else *tp = w; } }
    }
};
struct PairOrder {
    int G, c;
    __device__ __forceinline__ bool next(int i, Unit& u) const {
        StaticOrder s; s.init(8192, 2048, G, c);
        if (!s.next(i >> 1, u)) return false;
        const int pass = i & 1; u.pm += 32 * pass; u.pn += 8 * pass; return true;
    }
    __device__ __forceinline__ void a_ready(const Unit&) const {}
    __device__ __forceinline__ void done(const Unit&) const {}
};
struct EpiRes5 {
    static constexpr bool PERM = false, AFTER_DRAIN = false;
    const float* X; float* O;
    __device__ __forceinline__ void operator()(const f32x4 (&acc)[2][2][4][2], const Unit& u, int wr, int wc, int fr, int fq) const {
        const int row0 = u.pm * BM + wr * 64 + fr, col0 = u.pn * BM + wc * 32 + 4 * fq;
#pragma unroll
        for (int ai = 0; ai < 2; ++ai)
#pragma unroll
            for (int m = 0; m < 4; ++m) { const size_t off = (size_t)(row0 + ai * HALF + m * 16) * 2048 + col0;
#pragma unroll
                for (int bj = 0; bj < 2; ++bj)
#pragma unroll
                    for (int n = 0; n < 2; ++n) { const f32x4 xv = *(const f32x4*)(X + off + bj * HALF + n * 16);
                        *(f32x4*)(O + off + bj * HALF + n * 16) = xv * 1.189207115002721f + acc[ai][bj][m][n]; } }
    }
};
template <class Epi, class Sched, bool ALIGN_EPI = false, bool SP2 = false>
__device__ __forceinline__ void gemm_phase(int wv, PG8_LAS unsigned char* lds, const Gemm g, const Sched& S, const Epi& E) {
    int tid_ = tid_fresh(wv);
    const int tid = tid_, wid = wv, lane = tid & 63, wr = wid >> 2, wc = wid & 3, fr = lane & 15, fq = lane >> 4;
    const int K = g.K, nt = K / BK;
    unsigned voffA[2], voffB[2];
#pragma unroll
    for (int i = 0; i < 2; ++i) { int R, C; stage_rc(tid * 16 + i * 8192, R, C); const int Rb = Epi::PERM ? ((R & ~31) + perm32(R & 31)) : R;
        voffA[i] = (unsigned)(R * K + C) * 2u; voffB[i] = (unsigned)(Rb * K + C) * 2u; }
    const size_t kstep = (size_t)(BK * 2);
    const size_t hstep = (size_t)HALF * K * 2;
    const size_t tstep = 2 * hstep;
    const unsigned ldsw = (unsigned)wid * 1024u;
    const int aoff = lds_byte(wr * 64 + fr, fq * 8), boff = lds_byte(wc * 32 + fr, fq * 8);
#define PG8_SA(b, h) (((b) * 2 + (h)) * HTB)
#define PG8_SB(b, h) ((4 + (b) * 2 + (h)) * HTB)
#define PG8_STAGE(bufoff, gbase, voff) do { _Pragma("unroll") for (int _i = 0; _i < 2; ++_i) \
        __builtin_amdgcn_global_load_lds((const unsigned*)((const char*)(gbase) + (voff)[_i]), (PG8_LAS unsigned*)(lds + (bufoff) + ldsw + _i * 8192), 16, 0, 0); } while (0)
#define PG8_LDA(dst, b, h) do { _Pragma("unroll") for (int m = 0; m < 4; ++m) _Pragma("unroll") for (int k = 0; k < 2; ++k) dst[m][k] = *(const PG8_LAS bf16x8*)(lds + PG8_SA(b, h) + aoff + m * 2048 + k * 1024); } while (0)
#define PG8_LDB(dst, b, h) do { _Pragma("unroll") for (int n = 0; n < 2; ++n) _Pragma("unroll") for (int k = 0; k < 2; ++k) dst[n][k] = *(const PG8_LAS bf16x8*)(lds + PG8_SB(b, h) + boff + n * 2048 + k * 1024); } while (0)
#define PG8_MMA(ai, bj, At, Bt) do { __builtin_amdgcn_s_setprio(1); _Pragma("unroll") for (int m = 0; m < 4; ++m) _Pragma("unroll") for (int n = 0; n < 2; ++n) _Pragma("unroll") for (int k = 0; k < 2; ++k) \
        acc[ai][bj][m][n] = __builtin_amdgcn_mfma_f32_16x16x32_bf16(Bt[n][k], At[m][k], acc[ai][bj][m][n], 0, 0, 0); __builtin_amdgcn_s_setprio(0); } while (0)
#define PG8_WAIT_V(n) asm volatile("s_waitcnt vmcnt(" #n ")" ::: "memory")
#define PG8_WAIT_L(n) asm volatile("s_waitcnt lgkmcnt(" #n ")" ::: "memory")
#define PG8_BAR __builtin_amdgcn_s_barrier()
#define PG8_SCHED __builtin_amdgcn_sched_barrier(0)
    Unit cur, nxt; int ui = 0;
    if (!S.next(0, cur)) return;
    f32x4 acc[2][2][4][2];
#pragma unroll
    for (int a = 0; a < 2; ++a)
#pragma unroll
        for (int b = 0; b < 2; ++b)
#pragma unroll
            for (int m = 0; m < 4; ++m)
#pragma unroll
                for (int n = 0; n < 2; ++n) acc[a][b][m][n] = (f32x4){0.f, 0.f, 0.f, 0.f};
    bf16x8 At[4][2], B0[2][2], B1[2][2];
    const char* cA = (const char*)g.A + (size_t)cur.pm * tstep; const char* cB = (const char*)g.Bt + (size_t)cur.pn * tstep;
    S.a_ready(cur);
    if constexpr (SP2) {
        PG8_STAGE(PG8_SB(0, 0), cB, voffB); PG8_STAGE(PG8_SB(0, 1), cB + hstep, voffB); PG8_STAGE(PG8_SA(0, 0), cA, voffA); PG8_STAGE(PG8_SA(0, 1), cA + hstep, voffA);
        if (wr == 1) PG8_BAR;
        PG8_WAIT_V(2); PG8_BAR;
        PG8_STAGE(PG8_SB(1, 0), cB + kstep, voffB); PG8_STAGE(PG8_SA(1, 0), cA + kstep, voffA); PG8_STAGE(PG8_SB(1, 1), cB + hstep + kstep, voffB);
        PG8_WAIT_V(6); PG8_BAR;
    } else {
        PG8_STAGE(PG8_SB(0, 0), cB, voffB); PG8_STAGE(PG8_SA(0, 0), cA, voffA); PG8_STAGE(PG8_SB(0, 1), cB + hstep, voffB); PG8_STAGE(PG8_SA(0, 1), cA + hstep, voffA);
        if (wr == 1) PG8_BAR;
        PG8_WAIT_V(4); PG8_BAR;
        PG8_STAGE(PG8_SB(1, 0), cB + kstep, voffB); PG8_STAGE(PG8_SA(1, 0), cA + kstep, voffA); PG8_STAGE(PG8_SB(1, 1), cB + hstep + kstep, voffB);
        PG8_WAIT_V(6); PG8_BAR;
    }
    for (;;) {
        const bool has_next = S.next(ui + 1, nxt);
        const char* nA = has_next ? (const char*)g.A + (size_t)nxt.pm * tstep : cA; const char* nB = has_next ? (const char*)g.Bt + (size_t)nxt.pn * tstep : cB;
        for (int t = 0; t < nt; t += 2) {
            const bool last = (t == nt - 2);
            const char* a1 = cA + (size_t)(t + 1) * kstep;
            const char* a2 = last ? nA : cA + (size_t)(t + 2) * kstep; const char* b2 = last ? nB : cB + (size_t)(t + 2) * kstep;
            const char* a3 = a2 + kstep; const char* b3 = b2 + kstep;
            if (last && has_next) S.a_ready(nxt);
            if constexpr (SP2) {
            PG8_LDB(B0, 0, 0); PG8_LDB(B1, 0, 1); PG8_SCHED; PG8_LDA(At, 0, 0); PG8_STAGE(PG8_SA(1, 1), a1 + hstep, voffA);
            PG8_WAIT_V(8); PG8_WAIT_L(0); PG8_BAR; PG8_MMA(0, 0, At, B0); PG8_MMA(0, 1, At, B1); PG8_BAR; PG8_SCHED;
            PG8_LDA(At, 0, 1); PG8_STAGE(PG8_SB(0, 0), b2, voffB); PG8_STAGE(PG8_SB(0, 1), b2 + hstep, voffB); PG8_STAGE(PG8_SA(0, 0), a2, voffA);
            PG8_WAIT_V(8); PG8_WAIT_L(0); PG8_BAR; PG8_MMA(1, 0, At, B0); PG8_MMA(1, 1, At, B1); PG8_BAR; PG8_SCHED;
            PG8_LDB(B0, 1, 0); PG8_LDB(B1, 1, 1); PG8_SCHED; PG8_LDA(At, 1, 0); PG8_STAGE(PG8_SA(0, 1), a2 + hstep, voffA);
            PG8_WAIT_V(8); PG8_WAIT_L(0); PG8_BAR; PG8_MMA(0, 0, At, B0); PG8_MMA(0, 1, At, B1); PG8_BAR; PG8_SCHED;
            PG8_LDA(At, 1, 1); PG8_STAGE(PG8_SB(1, 0), b3, voffB); PG8_STAGE(PG8_SB(1, 1), b3 + hstep, voffB); PG8_STAGE(PG8_SA(1, 0), a3, voffA);
            PG8_WAIT_V(8); PG8_WAIT_L(0); PG8_BAR; PG8_MMA(1, 0, At, B0); PG8_MMA(1, 1, At, B1); PG8_BAR; PG8_SCHED;
            } else {
            PG8_LDB(B0, 0, 0); PG8_SCHED; PG8_LDA(At, 0, 0); PG8_STAGE(PG8_SA(1, 1), a1 + hstep, voffA);
            PG8_WAIT_L(8); PG8_BAR; PG8_WAIT_L(0); PG8_MMA(0, 0, At, B0); PG8_BAR; PG8_SCHED;
            PG8_LDB(B1, 0, 1); PG8_STAGE(PG8_SB(0, 0), b2, voffB);
            PG8_BAR; PG8_WAIT_L(0); PG8_MMA(0, 1, At, B1); PG8_BAR;
            PG8_LDA(At, 0, 1); PG8_STAGE(PG8_SA(0, 0), a2, voffA);
            PG8_BAR; PG8_WAIT_L(0); PG8_MMA(1, 0, At, B0); PG8_BAR; PG8_SCHED;
            PG8_STAGE(PG8_SB(0, 1), b2 + hstep, voffB);
            PG8_WAIT_V(6); PG8_BAR; PG8_MMA(1, 1, At, B1); PG8_BAR;
            PG8_LDB(B0, 1, 0); PG8_SCHED; PG8_LDA(At, 1, 0); PG8_STAGE(PG8_SA(0, 1), a2 + hstep, voffA);
            PG8_WAIT_L(8); PG8_BAR; PG8_WAIT_L(0); PG8_MMA(0, 0, At, B0); PG8_BAR; PG8_SCHED;
            PG8_LDB(B1, 1, 1); PG8_STAGE(PG8_SB(1, 0), b3, voffB);
            PG8_BAR; PG8_WAIT_L(0); PG8_MMA(0, 1, At, B1); PG8_BAR;
            PG8_LDA(At, 1, 1); PG8_STAGE(PG8_SA(1, 0), a3, voffA);
            PG8_BAR; PG8_WAIT_L(0); PG8_MMA(1, 0, At, B0); PG8_BAR; PG8_SCHED;
            PG8_STAGE(PG8_SB(1, 1), b3 + hstep, voffB);
            PG8_WAIT_V(6); PG8_BAR; PG8_MMA(1, 1, At, B1); PG8_BAR;
            }
        }
        if constexpr (ALIGN_EPI) { if (wr == 0) PG8_BAR; }
        if constexpr (!Epi::AFTER_DRAIN) { E(acc, cur, wr, wc, fr, fq); S.done(cur); }
        if (!has_next) break;
#pragma unroll
        for (int a = 0; a < 2; ++a)
#pragma unroll
            for (int b = 0; b < 2; ++b)
#pragma unroll
                for (int m = 0; m < 4; ++m)
#pragma unroll
                    for (int n = 0; n < 2; ++n) acc[a][b][m][n] = (f32x4){0.f, 0.f, 0.f, 0.f};
        cur = nxt; cA = nA; cB = nB; ++ui;
        if constexpr (ALIGN_EPI) { if (wr == 1) PG8_BAR; }
    }
    PG8_WAIT_V(0);
    if constexpr (!ALIGN_EPI) { if (wr == 0) PG8_BAR; }
    PG8_BAR;
    if constexpr (Epi::AFTER_DRAIN) { E.fused(acc, cur, wr, wc, fr, fq, lds, wid, lane); S.done(cur); }
#undef PG8_SA
#undef PG8_SB
#undef PG8_STAGE
#undef PG8_LDA
#undef PG8_LDB
#undef PG8_MMA
#undef PG8_WAIT_V
#undef PG8_WAIT_L
#undef PG8_BAR
#undef PG8_SCHED
}
}
__device__ __forceinline__ unsigned pk2(float lo, float hi) { return (unsigned)f2bf(lo) | ((unsigned)f2bf(hi) << 16); }
template <class CS>
__device__ __forceinline__ void transpose_item(const float* __restrict__ W, int K, int ldw, bf16_t* __restrict__ WT, int drow0, int k0, float* scr, int lane, const CS& csrc) {
    const int j = lane & 31; const int sc = csrc(j);
#pragma unroll 8
    for (int i = 0; i < 32; ++i) { const int kk = 2 * i + (lane >> 5); scr[kk * 33 + j] = sc >= 0 ? W[(size_t)(k0 + kk) * ldw + sc] : 0.f; }
    asm volatile("s_waitcnt lgkmcnt(0)" ::: "memory");
    const int c = lane & 7;
#pragma unroll
    for (int jj = 0; jj < 4; ++jj) { const int n = (lane >> 3) + 8 * jj; const float* s = scr + (8 * c) * 33 + n;
        uint4 o; o.x = pk2(s[0 * 33], s[1 * 33]); o.y = pk2(s[2 * 33], s[3 * 33]); o.z = pk2(s[4 * 33], s[5 * 33]); o.w = pk2(s[6 * 33], s[7 * 33]);
        *(uint4*)(WT + (size_t)(drow0 + n) * K + k0 + 8 * c) = o; }
    asm volatile("s_waitcnt lgkmcnt(0)" ::: "memory");
}
__device__ __forceinline__ void p0_phase(int wv, const Params& p, bf16_t* XB, bf16_t* WINT, bf16_t* WABT, bf16_t* WOT, bf16_t* W1T, bf16_t* W2T, float* POSW, unsigned char* lds) {
    const int tx = tid_fresh(wv); const int lane = tx & 63, wave = tx >> 6;
    float* scr = (float*)(lds + wave * 8704);
    const int gw = blockIdx.x * 8 + wave, NGW = gridDim.x * 8;
    constexpr int I_IN = 32 * 376, I_AB = 16 * 64, I_O = 32 * 64, I_1 = 64 * 8, I_2 = 4 * 4;
    for (int it = gw; it < I_IN + 2 * I_AB + I_O + 2 * I_1 + 2 * I_2; it += NGW) {
        int r = it;
        if (r < I_IN) { const int kb = r / 376, nb = r % 376, n0 = nb * 32;
            if (n0 < 11776) { const int s0 = n0 < 3072 ? n0 : (n0 < 6656 ? n0 + 8 : n0 + 32); transpose_item(p.in[1], 2048, INC, WINT, n0, kb * 64, scr, lane, [=](int j) { return s0 + j; }); }
            else if (n0 == 11776) transpose_item(p.in[1], 2048, INC, WINT, n0, kb * 64, scr, lane, [](int j) { return j < 8 ? 3072 + j : 6664 + (j - 8); });
            else transpose_item(p.in[1], 2048, INC, WINT, n0, kb * 64, scr, lane, [](int) { return -1; });
            continue; }
        r -= I_IN;
        if (r < I_AB) { const int kb = r / 64, n0 = (r % 64) * 32; transpose_item(p.in[9], 1024, 2048, WABT, n0, kb * 64, scr, lane, [=](int j) { return n0 + j; }); continue; }
        r -= I_AB;
        if (r < I_AB) { const int kb = r / 64, n0 = (r % 64) * 32; transpose_item(p.in[10], 1024, 2048, WABT, 2048 + n0, kb * 64, scr, lane, [=](int j) { return n0 + j; }); continue; }
        r -= I_AB;
        if (r < I_O) { const int kb = r / 64, n0 = (r % 64) * 32; transpose_item(p.in[11], 2048, 2048, WOT, n0, kb * 64, scr, lane, [=](int j) { return n0 + j; }); continue; }
        r -= I_O;
        if (r < 2 * I_1) { const int kv = r / I_1, q = r % I_1, kb = q / 8, n0 = (q % 8) * 32; transpose_item(kv ? p.in[7] : p.in[5], 4096, 256, W1T + (size_t)kv * 256 * 4096, n0, kb * 64, scr, lane, [=](int j) { return n0 + j; }); continue; }
        r -= 2 * I_1;
        { const int kv = r / I_2, q = r % I_2, kb = q / 4, n0 = (q % 4) * 32; transpose_item(kv ? p.in[8] : p.in[6], 256, 128, W2T + (size_t)kv * 128 * 256, n0, kb * 64, scr, lane, [=](int j) { return n0 + j; }); }
    }
    for (int o = gw; o < 512; o += NGW) { const int kv = o >> 8, n = o & 255; const float* pos = kv ? p.in[4] : p.in[3]; const float* w1 = kv ? p.in[7] : p.in[5];
        float a = 0.f;
        for (int kk = lane; kk < 4096; kk += 64) a += pos[kk] * w1[(size_t)kk * 256 + n];
#pragma unroll
        for (int sft = 32; sft > 0; sft >>= 1) a += __shfl_xor(a, sft);
        if (lane == 0) POSW[o] = a; }
    const float* x = p.in[0];
    for (size_t i = (size_t)blockIdx.x * NTHREADS + tx; i < (size_t)M_ * D_ / 8; i += (size_t)gridDim.x * NTHREADS) {
        const float4 a = *(const float4*)(x + i * 8), b = *(const float4*)(x + i * 8 + 4);
        uint4 o; o.x = pk2(a.x, a.y); o.y = pk2(a.z, a.w); o.z = pk2(b.x, b.y); o.w = pk2(b.z, b.w);
        *(uint4*)(XB + i * 8) = o;
    }
}


__device__ __forceinline__ void compress_fast_phase(int wv, const bf16_t* __restrict__ HB, const bf16_t* __restrict__ W1T, const bf16_t* __restrict__ W2T, const float* __restrict__ POSW,
                                                    bf16_t* __restrict__ KCMP, bf16_t* __restrict__ VCMP, unsigned char* lds) {
    typedef short bf16x8 __attribute__((ext_vector_type(8)));
    typedef float f32x16 __attribute__((ext_vector_type(16)));
    const int tid = tid_fresh(wv), lane = tid & 63, r32 = lane & 31, hi = lane >> 5, wid = wv;
    bf16_t* Hs = (bf16_t*)lds;
    for (int u = blockIdx.x; u < 64; u += gridDim.x) {
        const int kv = u & 1, g = (u >> 1) & 1, ct = (u >> 2) & 3, b = u >> 4;
        const int cl = min(ct * 32 + r32, NCMP - 1);
        const bf16_t* Ap = HB + (size_t)(b * S_ + 16 * cl) * PITCH + (kv ? H_VC : H_KC) + g * 128 + 8 * hi;
        const bf16_t* Bp = W1T + (size_t)kv * 256 * 4096 + (size_t)(wid * 32 + r32) * 4096 + 8 * hi;
        f32x16 acc = {};
        for (int l = 0; l < 32; ++l) {
            bf16x8 a[8], bq[8];
#pragma unroll
            for (int j = 0; j < 8; ++j) { a[j] = *(const bf16x8*)(Ap + (size_t)l * PITCH + j * 16); bq[j] = *(const bf16x8*)(Bp + l * 128 + j * 16); }
#pragma unroll
            for (int j = 0; j < 8; ++j) acc = __builtin_amdgcn_mfma_f32_32x32x16_bf16(a[j], bq[j], acc, 0, 0, 0);
        }
        const int n = wid * 32 + r32; const float pw = POSW[kv * 256 + n];
#pragma unroll
        for (int r = 0; r < 16; ++r) { const float v = acc[r] + pw; const float uu = 1.5957691216057308f * (v + 0.044715f * v * v * v);
            const float gl = v * __builtin_amdgcn_rcpf(1.f + __builtin_amdgcn_exp2f(-1.4426950408889634f * uu));
            Hs[((r & 3) + 8 * (r >> 2) + 4 * hi) * 264 + n] = f2bf(gl); }
        __syncthreads();
        if (wid < 4) {
            const bf16_t* B2 = W2T + (size_t)kv * 128 * 256 + (size_t)(wid * 32 + r32) * 256 + 8 * hi;
            f32x16 acc2 = {};
#pragma unroll
            for (int ks = 0; ks < 16; ++ks) { const bf16x8 a = *(const bf16x8*)(Hs + r32 * 264 + ks * 16 + 8 * hi); const bf16x8 bq = *(const bf16x8*)(B2 + ks * 16);
                acc2 = __builtin_amdgcn_mfma_f32_32x32x16_bf16(a, bq, acc2, 0, 0, 0); }
            bf16_t* out = (kv ? VCMP : KCMP) + (size_t)((b * 2 + g) * 128 + ct * 32) * 128 + wid * 32 + r32;
#pragma unroll
            for (int r = 0; r < 16; ++r) { const int row = (r & 3) + 8 * (r >> 2) + 4 * hi; out[(size_t)row * 128] = (ct * 32 + row < NCMP) ? f2bf(acc2[r]) : (bf16_t)0; }
        }
        __syncthreads();
    }
}

namespace att {
#define LAS __attribute__((address_space(3)))
typedef short bf16x8 __attribute__((ext_vector_type(8)));
typedef short s16x4 __attribute__((ext_vector_type(4)));
typedef float f32x16 __attribute__((ext_vector_type(16)));
typedef float f32x4 __attribute__((ext_vector_type(4)));
typedef unsigned u32x4 __attribute__((ext_vector_type(4)));
constexpr int QBLK = 32, KVBLK = 64;
constexpr int SHM_V = 16384, SHM_K = 16384;
constexpr int L_V = 0, L_K = 2 * SHM_V, L_WS = 65536, L_CN = L_WS + 2048, L_LUT = L_CN + 2048, L_IMPH = L_LUT + 4096, L_IMP2 = L_IMPH + 4 * 64 * 33 * 4, L_SELM = L_IMP2 + 64 * 33 * 4, L_QW = L_SELM + 256, L_END = L_QW + 64;
static_assert(L_END <= 131072, "attention LDS map");
constexpr float THR = 8.f;
constexpr float NEGINF = -__builtin_inff();

#define KSWZ(row, colB) ((row) * 256 + ((colB) ^ (((row) & 7) << 4)))
#define SBAR() __builtin_amdgcn_sched_barrier(0)
__device__ __forceinline__ int v_st(int k, int c) { const int kk = (k & ~0xC) | ((k & 4) << 1) | ((k & 8) >> 1); return ((kk >> 3) * 4 + (c >> 5)) * 512 + ((kk & 7) * 32 + (c & 31)) * 2; }
__device__ __forceinline__ int v_rd_base(int lane) { return ((lane & 3) << 3) | (((lane >> 2) & 3) << 6) | (((lane >> 4) & 1) << 5) | (((lane >> 5) & 1) << 8); }
constexpr int v_rd_off(int d0, int ks, int half) { return d0 * 512 + ks * 4096 + half * 2048; }
__device__ __forceinline__ int crow(int r, int hi) { return (r & 3) + 8 * (r >> 2) + 4 * hi; }
__device__ __forceinline__ unsigned cvtpk(float lo, float hi) { unsigned r; asm volatile("v_cvt_pk_bf16_f32 %0, %1, %2" : "=v"(r) : "v"(lo), "v"(hi)); return r; }

__device__ __forceinline__ void partialSM(f32x16& p0, f32x16& p1, float& m_reg, float& mn, float& alpha) {
    float pmax = p0[0];
#pragma unroll
    for (int r = 1; r < 16; ++r) pmax = fmaxf(pmax, p0[r]);
#pragma unroll
    for (int r = 0; r < 16; ++r) pmax = fmaxf(pmax, p1[r]);
    { auto rr = __builtin_amdgcn_permlane32_swap(__float_as_uint(pmax), __float_as_uint(pmax), false, false);
      pmax = fmaxf(__uint_as_float(rr[0]), __uint_as_float(rr[1])); }
    constexpr float C2 = 1.4426950408889634f * SCALE;
    if (__builtin_expect(__all((pmax - m_reg) * SCALE <= THR), 1)) { mn = m_reg; alpha = 1.f; }
    else { mn = fmaxf(m_reg, pmax); alpha = __builtin_amdgcn_exp2f((m_reg - mn) * C2); m_reg = mn; }
    const float mnL = -mn * C2;
#pragma unroll
    for (int r = 0; r < 16; ++r) p0[r] = fmaf(p0[r], C2, mnL);
#pragma unroll
    for (int r = 0; r < 16; ++r) p1[r] = fmaf(p1[r], C2, mnL);
#pragma unroll
    for (int r = 0; r < 16; ++r) p0[r] = __builtin_amdgcn_exp2f(p0[r]);
}
#define PK4(P, B_, OUT) do { unsigned a0 = cvtpk(P[B_+0], P[B_+1]), a1 = cvtpk(P[B_+2], P[B_+3]);                          \
        unsigned b0 = cvtpk(P[B_+4], P[B_+5]), b1 = cvtpk(P[B_+6], P[B_+7]);                                             \
        auto r0 = __builtin_amdgcn_permlane32_swap(a0, b0, false, false); auto r1 = __builtin_amdgcn_permlane32_swap(a1, b1, false, false); \
        u32x4 w = {r0[0], r1[0], r0[1], r1[1]}; OUT = *reinterpret_cast<bf16x8*>(&w); } while (0)
__device__ __forceinline__ void finishSM(f32x16& p0, f32x16& p1, float alpha, float& l_reg, bf16x8& pa0, bf16x8& pa1, bf16x8& pa2, bf16x8& pa3) {
#pragma unroll
    for (int r = 0; r < 16; ++r) p1[r] = __builtin_amdgcn_exp2f(p1[r]);
    float ps = 0;
#pragma unroll
    for (int r = 0; r < 16; ++r) ps += p0[r];
#pragma unroll
    for (int r = 0; r < 16; ++r) ps += p1[r];
    { auto rr = __builtin_amdgcn_permlane32_swap(__float_as_uint(ps), __float_as_uint(ps), false, false);
      ps = __uint_as_float(rr[0]) + __uint_as_float(rr[1]); }
    l_reg = l_reg * alpha + ps;
    PK4(p0, 0, pa0); PK4(p0, 8, pa1); PK4(p1, 0, pa2); PK4(p1, 8, pa3);
}
template <int KB, bool BIAS>
__device__ __forceinline__ void qkt(f32x16& p0, f32x16& p1, const LAS char* K_lds, const LAS char* cnb, int r32, int hi, const bf16x8* qr, bool act) {
    if (!act) {
#pragma unroll
        for (int r = 0; r < 16; ++r) { p0[r] = NEGINF; p1[r] = NEGINF; }
        return; }
    if (BIAS) {
        const bf16x8 c0 = *(const LAS bf16x8*)(cnb + KB * 1024 + r32 * 16);
        const bf16x8 c1 = *(const LAS bf16x8*)(cnb + KB * 1024 + 512 + r32 * 16);
        const short one = hi ? (short)0 : (short)0x3F80;
        const bf16x8 q1 = {one, one, one, 0, 0, 0, 0, 0};
        p0 = __builtin_amdgcn_mfma_f32_32x32x16_bf16(c0, q1, p0, 0, 0, 0);
        p1 = __builtin_amdgcn_mfma_f32_32x32x16_bf16(c1, q1, p1, 0, 0, 0);
    }
    const LAS char* kb[4];
#pragma unroll
    for (int dd = 0; dd < 4; ++dd) kb[dd] = K_lds + KB * SHM_K + KSWZ(r32, (dd * 16 + hi * 8) * 2);
#pragma unroll
    for (int d0 = 0; d0 < 8; ++d0) { const LAS char* a = kb[d0 & 3] + (d0 >> 2) * 128;
        bf16x8 b0 = *(const LAS bf16x8*)(a);
        bf16x8 b1 = *(const LAS bf16x8*)(a + 32 * 256);
        p0 = __builtin_amdgcn_mfma_f32_32x32x16_bf16(b0, qr[d0], p0, 0, 0, 0);
        p1 = __builtin_amdgcn_mfma_f32_32x32x16_bf16(b1, qr[d0], p1, 0, 0, 0); }
}
template <int VB>
__device__ __forceinline__ void pv_tile(f32x16* o, int vb0, bf16x8 pa0, bf16x8 pa1, bf16x8 pa2, bf16x8 pa3, bool act) {
    if (!act) return;
#define TRRD(dst, off) asm volatile("ds_read_b64_tr_b16 %0, %1 offset:%2" : "=&v"(dst) : "v"(vb0), "i"(off) : "memory")
#define PV_D0(d0) do { s16x4 l0, l1, l2, l3, h0, h1, h2, h3; constexpr int b_ = VB * SHM_V + v_rd_off(d0, 0, 0); \
        TRRD(l0, b_); TRRD(h0, b_ + 2048); TRRD(l1, b_ + 4096); TRRD(h1, b_ + 6144); TRRD(l2, b_ + 8192); TRRD(h2, b_ + 10240); TRRD(l3, b_ + 12288); TRRD(h3, b_ + 14336); \
        asm volatile("s_waitcnt lgkmcnt(0)" ::: "memory"); SBAR();   \
        o[d0] = __builtin_amdgcn_mfma_f32_32x32x16_bf16(pa0, (bf16x8){l0[0], l0[1], l0[2], l0[3], h0[0], h0[1], h0[2], h0[3]}, o[d0], 0, 0, 0);   \
        o[d0] = __builtin_amdgcn_mfma_f32_32x32x16_bf16(pa1, (bf16x8){l1[0], l1[1], l1[2], l1[3], h1[0], h1[1], h1[2], h1[3]}, o[d0], 0, 0, 0);   \
        o[d0] = __builtin_amdgcn_mfma_f32_32x32x16_bf16(pa2, (bf16x8){l2[0], l2[1], l2[2], l2[3], h2[0], h2[1], h2[2], h2[3]}, o[d0], 0, 0, 0);   \
        o[d0] = __builtin_amdgcn_mfma_f32_32x32x16_bf16(pa3, (bf16x8){l3[0], l3[1], l3[2], l3[3], h3[0], h3[1], h3[2], h3[3]}, o[d0], 0, 0, 0); } while (0)
    PV_D0(0); PV_D0(1); PV_D0(2); PV_D0(3);
#undef PV_D0
#undef TRRD
}

__device__ __forceinline__ void init_lut(f32x16& p0, f32x16& p1, const LAS float* lut, int dq1  ) {
#pragma unroll
    for (int r = 0; r < 16; ++r) { const int c = (r & 3) + 8 * (r >> 2);
        p0[r] = lut[min(max(dq1 - c, 0), 114)]; p1[r] = lut[min(max(dq1 - c - 32, 0), 114)]; }
}
__device__ __forceinline__ void init_lut_cmp(f32x16& p0, f32x16& p1, const LAS float* lut, int dq1  ) {
#pragma unroll
    for (int r = 0; r < 16; ++r) { const int c = 16 * ((r & 3) + 8 * (r >> 2));
        p0[r] = lut[min(max(dq1 - c, 0), 114)]; p1[r] = lut[min(max(dq1 - c - 512, 0), 114)]; }
}
__device__ __forceinline__ void init_const(f32x16& p0, f32x16& p1, float v) {
#pragma unroll
    for (int r = 0; r < 16; ++r) { p0[r] = v; p1[r] = v; }
}
__device__ __forceinline__ void init_edge(f32x16& p0, f32x16& p1, int dq  , int W) {
#pragma unroll
    for (int r = 0; r < 16; ++r) { const int c = (r & 3) + 8 * (r >> 2);
        p0[r] = (dq - c) < W ? 0.f : NEGINF; p1[r] = (dq - c - 32) < W ? 0.f : NEGINF; }
}
__device__ __forceinline__ void init_causal(f32x16& p0, f32x16& p1, int dq  ) {
#pragma unroll
    for (int r = 0; r < 16; ++r) { const int c = (r & 3) + 8 * (r >> 2);
        p0[r] = (dq - c) < 0 ? NEGINF : 0.f; p1[r] = (dq - c - 32) < 0 ? NEGINF : 0.f; }
}

template <int MODE, int pitch>
__device__ __forceinline__ void attn_pass(int wv, const bf16_t* __restrict__ Kp, const bf16_t* __restrict__ Vp, const bf16_t* __restrict__ CNp, int j_lo, int NT,
                                          const bf16x8* qr, int tpos, int qlo, unsigned selbits, const LAS float* lut, LAS char* lds, f32x16* o, float& l_out) {
    const int tid_ = tid_fresh(wv);
    const int tid = tid_, wid = wv, lane = tid & 63, r32 = lane & 31, hi = lane >> 5;
    LAS char* V_lds = lds + L_V; LAS char* K_lds = lds + L_K;
    LAS float* ws = (LAS float*)(lds + L_WS) + wid * 64; LAS float* al_l = ws + 32;
    LAS char* cnb = lds + L_CN;
    const int sr = tid >> 4, sc = (tid & 15) * 8, vst0 = v_st(sr, sc), vst1 = v_st(32 + sr, sc), kws = KSWZ(sr, sc * 2);
    const int vb0 = (int)(size_t)V_lds + v_rd_base(lane);
    float m_reg = -1e30f, l_reg = 0.f;
#pragma unroll
    for (int d = 0; d < 4; ++d) o[d] = f32x16{};
    bf16x8 st_v0, st_v1, st_k0, st_k1, st_cn;
#define KBASE(t) ((j_lo + (t)) * KVBLK)
#define ROWP(p, k0, rr) ((p) + (size_t)((k0) + (rr)) * pitch + sc)
#define VMW() asm volatile("s_waitcnt vmcnt(0)" ::: "memory")
#define SLOAD(t) do { const int k0_ = KBASE(t); st_v0 = *(const bf16x8*)ROWP(Vp, k0_, sr); st_v1 = *(const bf16x8*)ROWP(Vp, k0_, 32 + sr);              \
                      st_k0 = *(const bf16x8*)ROWP(Kp, k0_, sr); st_k1 = *(const bf16x8*)ROWP(Kp, k0_, 32 + sr);                                          \
                      if (MODE == 0) { if (tid < 64) st_cn = *(const bf16x8*)(CNp + (size_t)(k0_ + tid) * 8); } } while (0)
#define SWRITE(bf) do { *(LAS bf16x8*)(V_lds + (bf) * SHM_V + vst0) = st_v0; *(LAS bf16x8*)(V_lds + (bf) * SHM_V + vst1) = st_v1;                                 \
                        *(LAS bf16x8*)(K_lds + (bf) * SHM_K + kws) = st_k0; *(LAS bf16x8*)(K_lds + (bf) * SHM_K + kws + 32 * 256) = st_k1;                        \
                        if (MODE == 0) { if (tid < 64) *(LAS bf16x8*)(cnb + (bf) * 1024 + tid * 16) = st_cn; } } while (0)
#define RESC(a) do { if (__any((a) < 1.f)) { if (hi == 0) al_l[r32] = (a); asm volatile("s_waitcnt lgkmcnt(0)" ::: "memory");              \
                     _Pragma("unroll") for (int d_ = 0; d_ < 4; ++d_) _Pragma("unroll") for (int r = 0; r < 16; ++r) o[d_][r] *= al_l[crow(r, hi)]; } } while (0)
#define SELB(t) ((selbits >> (j_lo + (t))) & 1u)
#define ACT(t) (MODE == 2 ? (bool)__any(SELB(t)) : (MODE == 3 ? true : (KBASE(t) <= qlo + QBLK - 1)))
#define INIT(P0, P1, t, KB) do { const int kb_ = KBASE(t);                                                                                   \
        if (MODE == 0) { if (kb_ + KVBLK - 1 > qlo) init_causal(P0, P1, tpos - kb_ - 4 * hi); else init_const(P0, P1, 0.f); }                     \
        else { const bool near_ = kb_ + KVBLK - 1 > qlo - 113;                                                                                \
               if (near_) init_lut(P0, P1, lut, tpos - kb_ - 4 * hi + 1);                                                                    \
               else if (MODE == 3 && kb_ <= qlo + QBLK - 1 - 512) init_edge(P0, P1, tpos - kb_ - 4 * hi, 512);                                \
               else init_const(P0, P1, 0.f);                                                                                                 \
               if (MODE == 2) { if (!SELB(t)) init_const(P0, P1, NEGINF); } } } while (0)
    f32x16 p0, p1; float mn, al; bf16x8 pa0, pa1, pa2, pa3;
    SLOAD(0);
    __syncthreads();
    VMW(); SWRITE(0);
    __syncthreads();
#define STEP(t, BUF) do {                                                                                                     \
        if ((t) + 1 < NT) { SLOAD((t) + 1); }                                                                                  \
        SBAR(); INIT(p0, p1, t, BUF); qkt<BUF, MODE == 0>(p0, p1, K_lds, cnb, r32, hi, qr, ACT(t));                            \
        partialSM(p0, p1, m_reg, mn, al); RESC(al);                                                                            \
        finishSM(p0, p1, al, l_reg, pa0, pa1, pa2, pa3); SBAR();                                                               \
        pv_tile<BUF>(o, vb0, pa0, pa1, pa2, pa3, ACT(t));                                                                      \
        if ((t) + 1 < NT) { VMW(); SWRITE((BUF) ^ 1); }                                                                        \
        __syncthreads(); } while (0)
    int t = 0;
    for (; t + 1 < NT; t += 2) { STEP(t, 0); STEP(t + 1, 1); }
    if (t < NT) STEP(t, 0);
#undef STEP
    l_out = l_reg;
#undef KBASE
#undef ROWP
#undef SLOAD
#undef SWRITE
#undef RESC
#undef SELB
#undef ACT
#undef INIT
}

__device__ __forceinline__ void store_rows(const f32x16* o, const LAS float* rs, LAS bf16_t* stg, bf16_t* Orow0, size_t opitch, const bf16_t* Zrow0, size_t zpitch, int lane) {
    asm volatile("" : "+v"(lane));
    const int r32 = lane & 31, hi = lane >> 5;
#pragma unroll
    for (int r = 0; r < 16; ++r) { const int orow = crow(r, hi); const float s = rs[orow];
#pragma unroll
        for (int d0 = 0; d0 < 4; ++d0) stg[orow * 128 + d0 * 32 + r32] = f2bf(o[d0][r] * s); }
    asm volatile("s_waitcnt lgkmcnt(0)" ::: "memory");
#pragma unroll
    for (int i = 0; i < 8; ++i) { const int row = i * 4 + (lane >> 4), ch = lane & 15;
        const u32x4 v = *(const LAS u32x4*)(stg + row * 128 + ch * 8);
        const u32x4 z = *(const u32x4*)(Zrow0 + (size_t)row * zpitch + ch * 8);
        u32x4 w;
#pragma unroll
        for (int e = 0; e < 4; ++e) { const float a = __uint_as_float(v[e] << 16) * __uint_as_float(z[e] << 16), b = __uint_as_float(v[e] & 0xffff0000u) * __uint_as_float(z[e] & 0xffff0000u); w[e] = cvtpk(a, b); }
        *(u32x4*)(Orow0 + (size_t)row * opitch + ch * 8) = w; }
}

__device__ __forceinline__ void fox_unit(int wv, int b, int h, int qb, const bf16_t* __restrict__ HB, const bf16_t* __restrict__ CNB, bf16_t* __restrict__ OA, LAS char* lds) {
    const int tid = tid_fresh(wv), wid = wv, lane = tid & 63, r32 = lane & 31, hi = lane >> 5;
    const int q0 = qb * 256, qlo = q0 + wid * QBLK, tpos = qlo + r32;
    const bf16_t* Qrow = HB + (size_t)(b * S_ + tpos) * PITCH + H_FQ + h * 128;
    bf16x8 qr[8];
#pragma unroll
    for (int d0 = 0; d0 < 8; ++d0) qr[d0] = *(const bf16x8*)(Qrow + d0 * 16 + hi * 8);
    const bf16_t* Kp = HB + (size_t)(b * S_) * PITCH + H_FK + h * 128;
    const bf16_t* Vp = HB + (size_t)(b * S_) * PITCH + H_FV + h * 128;
    f32x16 o[4]; float l_reg;
    attn_pass<0, PITCH>(wv, Kp, Vp, CNB + (size_t)(b * 8 + h) * S_ * 8, 0, 4 * qb + 4, qr, tpos, qlo, 0u, nullptr, lds, o, l_reg);
    LAS float* ws = (LAS float*)(lds + L_WS) + wid * 64;
    if (hi == 0) ws[r32] = __builtin_amdgcn_rcpf(l_reg);
    __syncthreads();
    store_rows(o, ws, (LAS bf16_t*)(lds + wid * 8192), OA + (size_t)(b * S_ + qlo) * 1024 + h * 128, 1024, HB + (size_t)(b * S_ + qlo) * PITCH + H_FZ + h * 128, PITCH, lane);
}

__device__ __forceinline__ void scale_rows(f32x16* o, LAS float* wsw, float rowscale, int r32, int hi) {
    if (hi == 0) wsw[r32] = rowscale;
    asm volatile("s_waitcnt lgkmcnt(0)" ::: "memory");
#pragma unroll
    for (int r = 0; r < 16; ++r) { const float sc = wsw[crow(r, hi)];
#pragma unroll
        for (int d = 0; d < 4; ++d) o[d][r] *= sc; }
    asm volatile("s_waitcnt lgkmcnt(0)" ::: "memory");
}
__device__ __forceinline__ void scr_store(const f32x16* o, float* scr, int tid) {
#pragma unroll
    for (int d = 0; d < 4; ++d)
#pragma unroll
        for (int q = 0; q < 4; ++q) *(f32x4*)(scr + (size_t)((d * 4 + q) * 512 + tid) * 4) = (f32x4){o[d][4 * q], o[d][4 * q + 1], o[d][4 * q + 2], o[d][4 * q + 3]};
}
__device__ __forceinline__ void scr_add(f32x16* o, const float* scr, int tid) {
#pragma unroll
    for (int d = 0; d < 4; ++d)
#pragma unroll
        for (int q = 0; q < 4; ++q) { const f32x4 v = *(const f32x4*)(scr + (size_t)((d * 4 + q) * 512 + tid) * 4);
#pragma unroll
            for (int e = 0; e < 4; ++e) o[d][4 * q + e] += v[e]; }
}

__device__ __forceinline__ void nsa_unit(int wv, int b, int g, int cur, const bf16_t* __restrict__ HB, const bf16_t* __restrict__ KCMP, const bf16_t* __restrict__ VCMP,
                                         const float* __restrict__ NGATE, float* __restrict__ scr, bf16_t* __restrict__ OB, LAS char* lds) {
    const int tid_ = tid_fresh(wv);
    const int tid = tid_, wid = wv, lane = tid & 63, r32 = lane & 31, hi = lane >> 5;
    const int hp = wid >> 1, head = g * 4 + hp, qrow = (wid & 1) * 32 + r32, qlo = 64 * cur + (wid & 1) * 32, tpos = qlo + r32;
    const size_t trow = (size_t)(b * S_ + tpos);
    LAS float* wsw = (LAS float*)(lds + L_WS) + wid * 64;
    const LAS float* lut = (const LAS float*)(lds + L_LUT) + head * 128;
    bf16x8 qr[8];
    { const bf16_t* Qrow = HB + trow * PITCH + H_NQ + head * 128;
#pragma unroll
      for (int d0 = 0; d0 < 8; ++d0) qr[d0] = *(const bf16x8*)(Qrow + d0 * 16 + hi * 8); }
    f32x16 o[4];
    unsigned selbits;
    {
        LAS char* V_lds = lds + L_V; LAS char* K_lds = lds + L_K;
        const bool two = 64 * cur + 63 >= 1055;
        const int sr = tid >> 4, sc = (tid & 15) * 8;
        const bf16_t* Kc = KCMP + (size_t)(b * 2 + g) * 128 * 128; const bf16_t* Vc = VCMP + (size_t)(b * 2 + g) * 128 * 128;
        bf16x8 k0 = *(const bf16x8*)(Kc + (size_t)sr * 128 + sc), k1 = *(const bf16x8*)(Kc + (size_t)(32 + sr) * 128 + sc);
        bf16x8 v0 = *(const bf16x8*)(Vc + (size_t)sr * 128 + sc), v1 = *(const bf16x8*)(Vc + (size_t)(32 + sr) * 128 + sc);
        bf16x8 k2 = k0, k3 = k1, v2 = v0, v3 = v1;
        if (two) { k2 = *(const bf16x8*)(Kc + (size_t)(64 + sr) * 128 + sc); k3 = *(const bf16x8*)(Kc + (size_t)(96 + sr) * 128 + sc);
                   v2 = *(const bf16x8*)(Vc + (size_t)(64 + sr) * 128 + sc); v3 = *(const bf16x8*)(Vc + (size_t)(96 + sr) * 128 + sc); }
        __syncthreads();
        { const int vst0 = v_st(sr, sc), vst1 = v_st(32 + sr, sc), kws = KSWZ(sr, sc * 2);
          *(LAS bf16x8*)(V_lds + vst0) = v0; *(LAS bf16x8*)(V_lds + vst1) = v1; *(LAS bf16x8*)(K_lds + kws) = k0; *(LAS bf16x8*)(K_lds + kws + 32 * 256) = k1;
          if (two) { *(LAS bf16x8*)(V_lds + SHM_V + vst0) = v2; *(LAS bf16x8*)(V_lds + SHM_V + vst1) = v3; *(LAS bf16x8*)(K_lds + SHM_K + kws) = k2; *(LAS bf16x8*)(K_lds + SHM_K + kws + 32 * 256) = k3; } }
        __syncthreads();
        f32x16 pA0, pA1, pB0, pB1;
        init_lut_cmp(pA0, pA1, lut, tpos - 31 - 64 * hi + 1);
        qkt<0, false>(pA0, pA1, K_lds, nullptr, r32, hi, qr, true);
        if (two) { init_lut_cmp(pB0, pB1, lut, tpos - 31 - 16 * 64 - 64 * hi + 1); qkt<1, false>(pB0, pB1, K_lds, nullptr, r32, hi, qr, true); }
        else init_const(pB0, pB1, NEGINF);
        float mx = -1e30f;
#pragma unroll
        for (int r = 0; r < 16; ++r) mx = fmaxf(fmaxf(mx, pA0[r]), fmaxf(pA1[r], fmaxf(pB0[r], pB1[r])));
        { auto rr = __builtin_amdgcn_permlane32_swap(__float_as_uint(mx), __float_as_uint(mx), false, false); mx = fmaxf(__uint_as_float(rr[0]), __uint_as_float(rr[1])); }
        constexpr float C2 = 1.4426950408889634f * SCALE;
        const float mL = -mx * C2; float ps = 0.f;
#pragma unroll
        for (int r = 0; r < 16; ++r) { pA0[r] = __builtin_amdgcn_exp2f(fmaf(pA0[r], C2, mL)); pA1[r] = __builtin_amdgcn_exp2f(fmaf(pA1[r], C2, mL));
                                       pB0[r] = __builtin_amdgcn_exp2f(fmaf(pB0[r], C2, mL)); pB1[r] = __builtin_amdgcn_exp2f(fmaf(pB1[r], C2, mL));
                                       ps += (pA0[r] + pA1[r]) + (pB0[r] + pB1[r]); }
        { auto rr = __builtin_amdgcn_permlane32_swap(__float_as_uint(ps), __float_as_uint(ps), false, false); ps = __uint_as_float(rr[0]) + __uint_as_float(rr[1]); }
        const float inv = ps > 0.f ? 1.f / ps : 0.f;
#pragma unroll
        for (int r = 0; r < 16; ++r) { pA0[r] *= inv; pA1[r] *= inv; pB0[r] *= inv; pB1[r] *= inv; }
        if (cur >= 8) {
            LAS float* imph = (LAS float*)(lds + L_IMPH) + (hp * 64 + qrow) * 33;
            float up_prev = 0.f;
#define IMP_SLOTS(X, S0) do { _Pragma("unroll") for (int q = 0; q < 4; ++q) {                                                          \
                const float qs_ = (X[4 * q] + X[4 * q + 1]) + (X[4 * q + 2] + X[4 * q + 3]); const float le_ = X[4 * q + 3];            \
                auto rr = __builtin_amdgcn_permlane32_swap(__float_as_uint(le_), __float_as_uint(le_), false, false);                   \
                const float lo_ = __uint_as_float(rr[0]), up_ = __uint_as_float(rr[1]);                                               \
                imph[2 * ((S0) + q) + hi] = qs_ + (hi ? lo_ : up_prev); up_prev = up_; } } while (0)
            IMP_SLOTS(pA0, 0); IMP_SLOTS(pA1, 4); IMP_SLOTS(pB0, 8); IMP_SLOTS(pB1, 12);
#undef IMP_SLOTS
        }
        bf16x8 pa0, pa1, pa2, pa3;
#pragma unroll
        for (int d = 0; d < 4; ++d) o[d] = f32x16{};
        const int vb0 = (int)(size_t)V_lds + v_rd_base(lane);
        PK4(pA0, 0, pa0); PK4(pA0, 8, pa1); PK4(pA1, 0, pa2); PK4(pA1, 8, pa3);
        pv_tile<0>(o, vb0, pa0, pa1, pa2, pa3, true);
        if (two) { PK4(pB0, 0, pa0); PK4(pB0, 8, pa1); PK4(pB1, 0, pa2); PK4(pB1, 8, pa3); pv_tile<1>(o, vb0, pa0, pa1, pa2, pa3, true); }
        scale_rows(o, wsw, NGATE[trow * 24 + head * 3 + 0], r32, hi);
        scr_store(o, scr, tid);
        if (cur >= 8) {
            __syncthreads();
            LAS float* IH = (LAS float*)(lds + L_IMPH); LAS float* I2 = (LAS float*)(lds + L_IMP2);
            for (int i = tid; i < 2048; i += 512) { const int q = i >> 5, j = i & 31;
                I2[q * 33 + j] = ((IH[(0 * 64 + q) * 33 + j] + IH[(1 * 64 + q) * 33 + j]) + IH[(2 * 64 + q) * 33 + j]) + IH[(3 * 64 + q) * 33 + j]; }
            __syncthreads();
            if (wid == 0) {
                unsigned chosen = 1u | (1u << cur) | (1u << (cur - 1));
                for (int k = 0; k < 5; ++k) { float bv = -1.f; int bj = 0;
                    for (int j = 1; j <= cur - 2; ++j) { const float v = I2[lane * 33 + j]; if (!((chosen >> j) & 1u) && v > bv) { bv = v; bj = j; } }
                    chosen |= 1u << bj; }
                ((LAS unsigned*)(lds + L_SELM))[lane] = chosen;
            }
            __syncthreads();
            selbits = ((const LAS unsigned*)(lds + L_SELM))[qrow];
        } else selbits = (1u << (cur + 1)) - 1u;
    }
    float l_reg;
    attn_pass<2, PITCH>(wv, HB + (size_t)(b * S_) * PITCH + H_KS + g * 128, HB + (size_t)(b * S_) * PITCH + H_VS + g * 128, nullptr, 0, cur + 1, qr, tpos, qlo, selbits, lut, lds, o, l_reg);
    scale_rows(o, wsw, NGATE[(size_t)(b * S_ + tpos) * 24 + head * 3 + 1] * __builtin_amdgcn_rcpf(l_reg), r32, hi);
    scr_add(o, scr, tid);
    scr_store(o, scr, tid);
    { const int jl = cur >= 8 ? cur - 8 : 0;
      attn_pass<3, PITCH>(wv, HB + (size_t)(b * S_) * PITCH + H_KW + g * 128, HB + (size_t)(b * S_) * PITCH + H_VW + g * 128, nullptr, jl, cur + 1 - jl, qr, tpos, qlo, 0u, lut, lds, o, l_reg); }
    scale_rows(o, wsw, NGATE[(size_t)(b * S_ + tpos) * 24 + head * 3 + 2] * __builtin_amdgcn_rcpf(l_reg), r32, hi);
    scr_add(o, scr, tid);
    if (hi == 0) wsw[r32] = 1.f;
    __syncthreads();
    store_rows(o, wsw, (LAS bf16_t*)(lds + wid * 8192), OB + (size_t)(b * S_ + qlo) * 1024 + head * 128, 1024, HB + (size_t)(b * S_ + qlo) * PITCH + H_NZ + head * 128, PITCH, lane);
}
__device__ __forceinline__ void build_lut(int wv, const float* __restrict__ rel_bias, LAS char* lds) {
    LAS float* L = (LAS float*)(lds + L_LUT);
    for (int i = tid_fresh(wv); i < 1024; i += NTHREADS) { const int h = i >> 7, k = i & 127;
        L[i] = k == 0 ? NEGINF : (k <= 113 ? (rel_bias[rel_bucket(k - 1) * 8 + h] - rel_bias[31 * 8 + h]) * 11.313708498984761f : 0.f); }
    __syncthreads();
}

__device__ const unsigned short UNIT_ORDER[512] = {31,63,95,127,159,191,223,255,30,62,94,126,158,190,222,254,29,61,93,125,157,189,221,253,28,60,92,124,156,188,220,252,27,59,91,123,155,187,219,251,26,58,90,122,154,186,218,250,25,57,89,121,153,185,217,249,24,56,88,120,152,184,216,248,23,55,87,119,151,183,215,247,22,54,86,118,150,182,214,246,21,53,85,117,149,181,213,245,20,52,84,116,148,180,212,244,32775,32783,32791,32799,32807,32815,32823,32831,19,51,32839,32847,32855,32863,32871,32879,32887,32895,83,115,32903,32911,32919,32927,32935,32943,32951,32959,147,179,32967,32975,32983,32991,32999,33007,33015,33023,211,243,18,50,82,114,146,178,210,242,17,49,81,113,145,177,209,241,16,48,80,112,144,176,208,240,32774,32782,32790,32798,32806,32814,32822,32830,15,47,32838,32846,32854,32862,32870,32878,32886,32894,79,111,32902,32910,32918,32926,32934,32942,32950,32958,143,175,32966,32974,32982,32990,32998,33006,33014,33022,207,239,14,46,78,110,142,174,206,238,13,45,77,109,141,173,205,237,12,44,76,108,140,172,204,236,32773,32781,32789,32797,32805,32813,32821,32829,11,43,32837,32845,32853,32861,32869,32877,32885,32893,75,107,32901,32909,32917,32925,32933,32941,32949,32957,139,171,32965,32973,32981,32989,32997,33005,33013,33021,203,235,10,42,74,106,138,170,202,234,9,41,73,105,137,169,201,233,8,40,72,104,136,168,200,232,32772,32780,32788,32796,32804,32812,32820,32828,32836,32844,32852,32860,32868,32876,32884,32892,32900,32908,32916,32924,32932,32940,32948,32956,32964,32972,32980,32988,32996,33004,33012,33020,7,39,71,103,135,167,199,231,6,38,70,102,134,166,198,230,32771,32779,32787,32795,32803,32811,32819,32827,32835,32843,32851,32859,32867,32875,32883,32891,32899,32907,32915,32923,32931,32939,32947,32955,32963,32971,32979,32987,32995,33003,33011,33019,5,37,69,101,133,165,197,229,4,36,68,100,132,164,196,228,32770,32778,32786,32794,32802,32810,32818,32826,32834,32842,32850,32858,32866,32874,32882,32890,32898,32906,32914,32922,32930,32938,32946,32954,32962,32970,32978,32986,32994,33002,33010,33018,3,35,67,99,131,163,195,227,2,34,66,98,130,162,194,226,32769,32777,32785,32793,32801,32809,32817,32825,32833,32841,32849,32857,32865,32873,32881,32889,32897,32905,32913,32921,32929,32937,32945,32953,32961,32969,32977,32985,32993,33001,33009,33017,1,33,65,97,129,161,193,225,0,32,64,96,128,160,192,224,32768,32776,32784,32792,32800,32808,32816,32824,32832,32840,32848,32856,32864,32872,32880,32888,32896,32904,32912,32920,32928,32936,32944,32952,32960,32968,32976,32984,32992,33000,33008,33016};
__device__ __forceinline__ void attn_phase(int wv, const bf16_t* __restrict__ HB, const bf16_t* __restrict__ CNB, const bf16_t* __restrict__ KCMP, const bf16_t* __restrict__ VCMP,
                                           const float* __restrict__ NGATE, const float* __restrict__ rel_bias, float* __restrict__ scr, bf16_t* __restrict__ OA, bf16_t* __restrict__ OB,
                                           unsigned* __restrict__ qctr, LAS char* lds) {
    build_lut(wv, rel_bias, lds);
    volatile LAS unsigned* qw = (volatile LAS unsigned*)(lds + L_QW);
    for (;;) {
        if (tid_fresh(wv) == 0) qw[0] = atomicAdd(qctr, 1u);
        __syncthreads();
        const unsigned i = qw[0];
        __syncthreads();
        if (i >= 512u) break;
        const unsigned u = UNIT_ORDER[i];
        if (u & 0x8000u) fox_unit(wv, (int)((u >> 6) & 3u), (int)((u >> 3) & 7u), (int)(u & 7u), HB, CNB, OA, lds);
        else nsa_unit(wv, (int)((u >> 6) & 3u), (int)((u >> 5) & 1u), (int)(u & 31u), HB, KCMP, VCMP, NGATE, scr, OB, lds);
    }
}
#undef KSWZ
#undef SBAR
#undef PK4
#undef VMW
#undef LAS
}

#define RLX_AGENT __ATOMIC_RELAXED, __HIP_MEMORY_SCOPE_AGENT
#define XB_TMO      128
#define XB_XCNT(j)  (256  + 64 * (j))
#define XB_XSUB(j)  (1280 + 64 * (j))
#define XB_XGEN(j)  (2304 + 64 * (j))
#define XB_TOP      3328
#define XB_TOPGEN   3392
#define XCD_BAR_WORDS 3456
#define XB_SPIN_CAP (1u << 18)

__device__ __forceinline__ unsigned xb_ld(unsigned* p)              { return __hip_atomic_load(p, __ATOMIC_RELAXED, __HIP_MEMORY_SCOPE_AGENT); }
__device__ __forceinline__ unsigned xb_add(unsigned* p, unsigned v) { return __hip_atomic_fetch_add(p, v, __ATOMIC_RELAXED, __HIP_MEMORY_SCOPE_AGENT); }
__device__ __forceinline__ unsigned xb_xcc_id() { return (unsigned)__builtin_amdgcn_s_getreg((3 << 11) | 20) & 0xFu; }
#define XB_SPIN(cond, bar) do { unsigned _sp = 0; while (cond) { __builtin_amdgcn_s_sleep(1); \
    if ((++_sp & 255u) == 0u) { if (xb_ld(&(bar)[XB_TMO])) break; if (_sp > XB_SPIN_CAP) { atomicAdd(&(bar)[XB_TMO], 1u); break; } } } } while (0)

struct XcdBarrier {
    unsigned* bar; unsigned x;
    volatile __attribute__((address_space(3))) unsigned* st;
};

__device__ __forceinline__ XcdBarrier xcd_barrier_post(unsigned* bar, volatile __attribute__((address_space(3))) unsigned* st) {
    XcdBarrier b; b.bar = bar; b.x = xb_xcc_id(); b.st = st;
    if (threadIdx.x == 0) (void)xb_add(&bar[XB_XCNT(b.x)], 1u);
    return b;
}
__device__ __forceinline__ void xcd_barrier_complete(unsigned* bar, unsigned x, unsigned& nloc, unsigned& nx) {
    const unsigned G = gridDim.x * gridDim.y * gridDim.z;
    unsigned sum, cnt, mine, sp = 0u;
    for (;;) {
        sum = 0u; cnt = 0u; mine = 0u;
#pragma unroll
        for (unsigned j = 0; j < 16; ++j) { const unsigned c = xb_ld(&bar[XB_XCNT(j)]); sum += c; cnt += (c > 0u) ? 1u : 0u; mine = (j == x) ? c : mine; }
        if (sum == G) break;
        __builtin_amdgcn_s_sleep(1);
        if ((++sp & 255u) == 0u) { if (xb_ld(&bar[XB_TMO])) break; if (sp > XB_SPIN_CAP) { atomicAdd(&bar[XB_TMO], 1u); break; } }
    }
    nloc = mine > 0u ? mine : 1u; nx = cnt > 0u ? cnt : 1u;
}

__device__ __forceinline__ void xcd_barrier(const XcdBarrier& b) {
    asm volatile("s_waitcnt vmcnt(0)" ::: "memory");
    __syncthreads();
    if (threadIdx.x == 0) {
        unsigned* bar = b.bar;
        __builtin_amdgcn_s_waitcnt(0);
        unsigned nloc = b.st[0], nx = b.st[1];
        if (nloc == 0u) { xcd_barrier_complete(bar, b.x, nloc, nx); b.st[0] = nloc; b.st[1] = nx; }
        const unsigned old = xb_add(&bar[XB_XSUB(b.x)], 1u);
        const unsigned gen = old / nloc;
        if (old + 1u == (gen + 1u) * nloc) {
            __builtin_amdgcn_fence(__ATOMIC_RELEASE, "agent");
            asm volatile("s_waitcnt vmcnt(0)" ::: "memory");
            const unsigned og = xb_add(&bar[XB_TOP], 1u);
            const unsigned tg = og / nx;
            if (og + 1u == (tg + 1u) * nx) xb_add(&bar[XB_TOPGEN], 1u);
            else XB_SPIN(xb_ld(&bar[XB_TOPGEN]) == tg, bar);
            __builtin_amdgcn_fence(__ATOMIC_ACQUIRE, "agent");
            xb_add(&bar[XB_XGEN(b.x)], 1u);
            asm volatile("s_waitcnt vmcnt(0)" ::: "memory");
        } else {
            XB_SPIN(xb_ld(&bar[XB_XGEN(b.x)]) == gen, bar);
            __builtin_amdgcn_fence(__ATOMIC_ACQUIRE, "agent");
            asm volatile("s_waitcnt vmcnt(0)" ::: "memory");
        }
    }
    __syncthreads();
}


__global__ void __launch_bounds__(NTHREADS, 2) fwd_megakernel(const float* i0, const float* i1, const float* i2, const float* i3, const float* i4, const float* i5, const float* i6, const float* i7,
                                                               const float* i8, const float* i9, const float* i10, const float* i11, const float* i12, const float* i13, const float* i14,
                                                               float* out_, unsigned char* ws_) {
    Params p; p.in[0] = i0; p.in[1] = i1; p.in[2] = i2; p.in[3] = i3; p.in[4] = i4; p.in[5] = i5; p.in[6] = i6; p.in[7] = i7; p.in[8] = i8; p.in[9] = i9; p.in[10] = i10; p.in[11] = i11;
    p.in[12] = i12; p.in[13] = i13; p.in[14] = i14; p.out = out_; p.ws = ws_;
    extern __shared__ __attribute__((aligned(16))) unsigned char lds[];
    const int wv = __builtin_amdgcn_readfirstlane(threadIdx.x >> 6);
    PG8_LAS unsigned char* ldsl = (PG8_LAS unsigned char*)lds;
    volatile PG8_LAS unsigned* bst = (volatile PG8_LAS unsigned*)(ldsl + 131072 + 512);
    if (wv == 0) { bst[0] = 0u; bst[1] = 0u; }
    __syncthreads();
    XcdBarrier bar = xcd_barrier_post((unsigned*)(p.ws + WS_CTL) + 4096, bst);
#define WSP(name) size_t name##_z = 0; asm volatile("" : "+s"(name##_z)); unsigned char* name = p.ws + name##_z
    { WSP(ws); p0_phase(wv, p, (bf16_t*)(ws + WS_XB), (bf16_t*)(ws + WS_WINT), (bf16_t*)(ws + WS_WABT), (bf16_t*)(ws + WS_WOT), (bf16_t*)(ws + WS_W1T), (bf16_t*)(ws + WS_W2T), (float*)(ws + WS_POSW), lds); }
    xcd_barrier(bar);
    { WSP(ws); pg8::Gemm g{(bf16_t*)(ws + WS_XB), (bf16_t*)(ws + WS_WINT), M_, 12032, 2048}; pg8::StaticOrder S; S.init(M_, 12032, (int)gridDim.x, (int)blockIdx.x);
      pg8::EpiH1 E{(bf16_t*)(ws + WS_HB), (float*)(ws + WS_LOGF), (float*)(ws + WS_NGATE), p.in[2]};
      pg8::gemm_phase<pg8::EpiH1, pg8::StaticOrder, true, true>(wv, ldsl, g, S, E); }
    xcd_barrier(bar);
    { WSP(ws); cumsum_phase(wv, (float*)(ws + WS_LOGF), (bf16_t*)(ws + WS_CN));
      compress_fast_phase(wv, (bf16_t*)(ws + WS_HB), (bf16_t*)(ws + WS_W1T), (bf16_t*)(ws + WS_W2T), (float*)(ws + WS_POSW), (bf16_t*)(ws + WS_KCMP), (bf16_t*)(ws + WS_VCMP), lds); }
    xcd_barrier(bar);
    { WSP(ws); att::attn_phase(wv, (bf16_t*)(ws + WS_HB), (bf16_t*)(ws + WS_CN), (bf16_t*)(ws + WS_KCMP), (bf16_t*)(ws + WS_VCMP), (float*)(ws + WS_NGATE), p.in[14],
                      (float*)(ws + WS_T1B) + (size_t)blockIdx.x * 32768, (bf16_t*)(ws + WS_OA), (bf16_t*)(ws + WS_OB), (unsigned*)(ws + WS_CTL) + 64, (PG8_LAS char*)lds); }
    xcd_barrier(bar);
    { WSP(ws); pg8::Gemm g{(bf16_t*)(ws + WS_OA), (bf16_t*)(ws + WS_WABT), 2 * M_, 4096, 1024}; pg8::PairOrder S{(int)gridDim.x, (int)blockIdx.x};
      pg8::EpiMerge E{(bf16_t*)(ws + WS_HB), (pg8::u32x4*)(ws + WS_T1B), (bf16_t*)(ws + WS_MRG)};
      pg8::gemm_phase<pg8::EpiMerge, pg8::PairOrder, true, true>(wv, ldsl, g, S, E); }
    xcd_barrier(bar);
    { WSP(ws); pg8::Gemm g{(bf16_t*)(ws + WS_MRG), (bf16_t*)(ws + WS_WOT), M_, 2048, 2048}; pg8::StaticOrder S; S.init(M_, 2048, (int)gridDim.x, (int)blockIdx.x);
      pg8::EpiRes5 E{p.in[0], p.out};
      pg8::gemm_phase<pg8::EpiRes5, pg8::StaticOrder, true, true>(wv, ldsl, g, S, E); }
    xcd_barrier(bar);
    ln_phase(wv, p.out, p.in[12], p.in[13], lds);
#undef WSP
}
}

extern "C" void kernel_launch(void* const* d_in, const int* in_sizes, int n_in, void* d_out, int out_size, void* d_ws, size_t ws_size, hipStream_t stream) {
    static int grid_blocks = 0;
    if (grid_blocks == 0) {
        if (n_in != 15 || ws_size < WS_END || out_size != M_ * D_) { fprintf(stderr, "kernel_launch: unexpected shapes/ws (%d inputs, ws %zu, out %d)\n", n_in, ws_size, out_size); grid_blocks = -1; return; }
        int dev = 0, cus = 0, per_cu = 0;
        (void)hipGetDevice(&dev);
        (void)hipDeviceGetAttribute(&cus, hipDeviceAttributeMultiprocessorCount, dev);
        if (hipFuncSetAttribute((const void*)fwd_megakernel, hipFuncAttributeMaxDynamicSharedMemorySize, LDS_BYTES) != hipSuccess) { fprintf(stderr, "kernel_launch: hipFuncSetAttribute failed\n"); grid_blocks = -1; return; }
        (void)hipOccupancyMaxActiveBlocksPerMultiprocessor(&per_cu, (const void*)fwd_megakernel, NTHREADS, LDS_BYTES);
        if (per_cu < 1) { fprintf(stderr, "kernel_launch: occupancy query says %d blocks/CU\n", per_cu); grid_blocks = -1; return; }
        grid_blocks = cus;
        fprintf(stderr, "kernel_launch: %d CUs, occupancy %d/CU, grid %d, ws %zu\n", cus, per_cu, grid_blocks, ws_size);
    }
    if (grid_blocks < 0) return;
    (void)hipMemsetAsync((char*)d_ws + WS_CTL, 0, 65536, stream);
    void* ptrs[17];
    for (int i = 0; i < 15; ++i) ptrs[i] = d_in[i];
    ptrs[15] = d_out; ptrs[16] = d_ws;
    void* args[17];
    for (int i = 0; i < 17; ++i) args[i] = &ptrs[i];
    hipError_t e = hipLaunchCooperativeKernel((const void*)fwd_megakernel, dim3(grid_blocks), dim3(NTHREADS), args, LDS_BYTES, stream);
    if (e != hipSuccess) fprintf(stderr, "cooperative launch failed: %s (grid %d)\n", hipGetErrorString(e), grid_blocks);
}
```

```cpp
#include <hip/hip_runtime.h>
#include <cstdio>
#include <cstdint>

namespace {
constexpr int B_ = 4, S_ = 2048, D_ = 2048, M_ = B_ * S_;
constexpr int INC = 11808;
constexpr int NCMP = 127;
constexpr float SCALE = 0.08838834764831845f;
constexpr float ALPHA = 1.189207115002721f;
constexpr int PITCH = 11776;
constexpr int H_FQ = 0, H_FK = 1024, H_FV = 2048, H_FZ = 3072, H_NQ = 4096, H_KC = 5120, H_VC = 5376, H_KS = 5632, H_VS = 5888,
              H_KW = 6144, H_VW = 6400, H_NZ = 6656, H_GA = 7680, H_GB = 9728;
constexpr size_t MiB = 1u << 20;
constexpr size_t WS_CTL = 0;
constexpr size_t WS_HB = 1 * MiB;
constexpr size_t WS_CN = 185 * MiB;
constexpr size_t WS_LOGF = 186 * MiB;
constexpr size_t WS_NGATE = 187 * MiB;
constexpr size_t WS_CC = 188 * MiB;
constexpr size_t WS_KCMP = 189 * MiB;
constexpr size_t WS_VCMP = 190 * MiB;
constexpr size_t WS_SEL = 191 * MiB;
constexpr size_t WS_OA = 192 * MiB;
constexpr size_t WS_OB = 208 * MiB;
constexpr size_t WS_MRG = 224 * MiB;
constexpr size_t WS_PC = 256 * MiB;
constexpr size_t WS_OAF = 288 * MiB;
constexpr size_t WS_OBF = 320 * MiB;
constexpr size_t WS_XB = 256 * MiB;
constexpr size_t WS_WINT = 288 * MiB;
constexpr size_t WS_T1B = 256 * MiB;
constexpr size_t WS_WABT = 352 * MiB;
constexpr size_t WS_WOT = 360 * MiB;
constexpr size_t WS_W1T = 335 * MiB;
constexpr size_t WS_W2T = 339 * MiB;
constexpr size_t WS_POSW = 340 * MiB;
constexpr size_t WS_HID = 341 * MiB;
constexpr size_t WS_END = 368 * MiB;

constexpr int NTHREADS = 512;
constexpr int LDS_BYTES = 147456;

typedef unsigned short bf16_t;
__device__ __forceinline__ float bf2f(bf16_t v) { return __uint_as_float((unsigned)v << 16); }
__device__ __forceinline__ bf16_t f2bf(float f) { unsigned u = __float_as_uint(f); return (bf16_t)((u + 0x7fffu + ((u >> 16) & 1u)) >> 16); }

__device__ __forceinline__ int tid_fresh(int wv) { int t = wv * 64 + (int)__builtin_amdgcn_mbcnt_hi(~0u, __builtin_amdgcn_mbcnt_lo(~0u, 0u)); asm volatile("" : "+v"(t)); return t; }
__device__ __forceinline__ int rel_bucket(int n) {
    if (n < 16) return n < 0 ? 0 : n;
    int b = 16;
    b += n >= 19; b += n >= 21; b += n >= 24; b += n >= 27; b += n >= 31; b += n >= 35; b += n >= 40; b += n >= 46;
    b += n >= 52; b += n >= 59; b += n >= 67; b += n >= 77; b += n >= 87; b += n >= 99; b += n >= 113;
    return b;
}
__device__ __forceinline__ float sigmoidf_(float v) { return 1.f / (1.f + expf(-v)); }
__device__ __forceinline__ float siluf_(float v) { return v / (1.f + expf(-v)); }
__device__ __forceinline__ float log_sigmoidf_(float v) { return fminf(v, 0.f) - log1pf(expf(-fabsf(v))); }
__device__ __forceinline__ float gelu_tanh(float v) { return 0.5f * v * (1.f + tanhf(0.7978845608028654f * (v + 0.044715f * v * v * v))); }

struct Params { const float* in[15]; float* out; unsigned char* ws; };

template <class TA> __device__ __forceinline__ float4 ld4(const TA* p);
template <> __device__ __forceinline__ float4 ld4<float>(const float* p) { return *(const float4*)p; }
template <> __device__ __forceinline__ float4 ld4<bf16_t>(const bf16_t* p) { const uint2 u = *(const uint2*)p; return make_float4(__uint_as_float(u.x << 16), __uint_as_float(u.x & 0xffff0000u), __uint_as_float(u.y << 16), __uint_as_float(u.y & 0xffff0000u)); }

template <class TA, class Epi>
__device__ __forceinline__ void gemm_naive_phase(int wv, const TA* __restrict__ A, const float* __restrict__ Bm, int lda, int ldb, int Mr, int N, int K, const Epi& epi, unsigned char* lds) {
    const int tf = tid_fresh(wv); const int half = tf >> 8, tid = tf & 255, tx = tid & 15, ty = tid >> 4;
    float (*As)[68] = (float (*)[68])(lds + half * 8704);
    float (*Bs)[68] = (float (*)[68])(lds + half * 8704 + 4352);
    const int ntn = (N + 63) / 64, nvb = (Mr / 64) * ntn, stride = gridDim.x * 2;
    const int iters = (nvb + stride - 1) / stride;
    const int ar = tid >> 2, ac = (tid & 3) * 4, br = tid >> 4, bc = (tid & 15) * 4;
    for (int it = 0; it < iters; ++it) {
        const int vb = it * stride + blockIdx.x * 2 + half;
        const bool act = vb < nvb;
        const int m0 = act ? (vb / ntn) * 64 : 0, n0 = act ? (vb % ntn) * 64 : 0;
        float acc[4][4];
#pragma unroll
        for (int i = 0; i < 4; ++i)
#pragma unroll
            for (int j = 0; j < 4; ++j) acc[i][j] = 0.f;
        for (int k0 = 0; k0 < K; k0 += 16) {
            const float4 a = ld4<TA>(A + (size_t)(m0 + ar) * lda + k0 + ac);
            As[ac + 0][ar] = a.x; As[ac + 1][ar] = a.y; As[ac + 2][ar] = a.z; As[ac + 3][ar] = a.w;
            float4 b = make_float4(0.f, 0.f, 0.f, 0.f);
            if (n0 + bc < N) b = *(const float4*)(Bm + (size_t)(k0 + br) * ldb + n0 + bc);
            *(float4*)&Bs[br][bc] = b;
            __syncthreads();
#pragma unroll
            for (int kk = 0; kk < 16; ++kk) {
                const float4 av = *(const float4*)&As[kk][ty * 4];
                const float4 bv = *(const float4*)&Bs[kk][tx * 4];
                const float aa[4] = {av.x, av.y, av.z, av.w}, bb[4] = {bv.x, bv.y, bv.z, bv.w};
#pragma unroll
                for (int i = 0; i < 4; ++i)
#pragma unroll
                    for (int j = 0; j < 4; ++j) acc[i][j] += aa[i] * bb[j];
            }
            __syncthreads();
        }
        if (act) {
#pragma unroll
            for (int i = 0; i < 4; ++i)
#pragma unroll
                for (int j = 0; j < 4; ++j) { const int n = n0 + tx * 4 + j; if (n < N) epi(m0 + ty * 4 + i, n, acc[i][j]); }
        }
    }
}
struct EpiH {
    bf16_t* HB; float* LOGF; float* NGATE; const float* b_f;
    __device__ __forceinline__ void operator()(int m, int n, float a) const {
        if (n < 3072) HB[(size_t)m * PITCH + n] = f2bf(a);
        else if (n < 3080) LOGF[(size_t)m * 8 + (n - 3072)] = log_sigmoidf_(a + b_f[n - 3072]);
        else if (n < 4104) HB[(size_t)m * PITCH + n - 8] = f2bf(siluf_(a));
        else if (n < 6664) HB[(size_t)m * PITCH + n - 8] = f2bf(a);
        else if (n < 6688) NGATE[(size_t)m * 24 + (n - 6664)] = sigmoidf_(a);
        else if (n < 7712) HB[(size_t)m * PITCH + n - 32] = f2bf(siluf_(a));
        else HB[(size_t)m * PITCH + n - 32] = f2bf(sigmoidf_(a));
    }
};
struct EpiGateA { const bf16_t* HB; float* T1; __device__ __forceinline__ void operator()(int m, int n, float a) const { T1[(size_t)m * 2048 + n] = bf2f(HB[(size_t)m * PITCH + H_GA + n]) * a; } };
struct EpiGateB { const bf16_t* HB; const float* T1; bf16_t* MRG; __device__ __forceinline__ void operator()(int m, int n, float a) const { MRG[(size_t)m * 2048 + n] = f2bf(T1[(size_t)m * 2048 + n] + bf2f(HB[(size_t)m * PITCH + H_GB + n]) * a); } };
struct EpiRes { const float* X; float* O; __device__ __forceinline__ void operator()(int m, int n, float a) const { O[(size_t)m * D_ + n] = ALPHA * X[(size_t)m * D_ + n] + a; } };

__device__ __forceinline__ void cumsum_phase(int wv, const float* __restrict__ LOGF, bf16_t* __restrict__ CN) {
    const int tx = tid_fresh(wv); const int lane = tx & 63, gw = blockIdx.x * (NTHREADS / 64) + (tx >> 6);
    if (gw >= B_ * 8) return;
    const int b = gw >> 3, h = gw & 7;
    double run = 0.0;
    for (int i = 0; i < 32; ++i) run += (double)LOGF[(size_t)(b * S_ + lane * 32 + i) * 8 + h];
    double incl = run;
#pragma unroll
    for (int o = 1; o < 64; o <<= 1) { const double v = __shfl_up(incl, o); if (lane >= o) incl += v; }
    double base = incl - run;
    for (int i = 0; i < 32; ++i) { base += (double)LOGF[(size_t)(b * S_ + lane * 32 + i) * 8 + h];         { const float v = (float)(-base * 11.313708498984761); const bf16_t h0 = f2bf(v); const float r1 = v - bf2f(h0); const bf16_t h1 = f2bf(r1); const bf16_t h2 = f2bf(r1 - bf2f(h1));
          uint4 w; w.x = (unsigned)h0 | ((unsigned)h1 << 16); w.y = (unsigned)h2; w.z = 0u; w.w = 0u; *(uint4*)(CN + ((size_t)gw * S_ + lane * 32 + i) * 8) = w; } }
}

__device__ __forceinline__ void ln_phase(int wv, float* __restrict__ X, const float* __restrict__ g, const float* __restrict__ bta, unsigned char* lds) {
    const int lane = tid_fresh(wv) & 63;
    for (int r = blockIdx.x * 8 + wv; r < M_; r += gridDim.x * 8) {
        float4* xr = (float4*)(X + (size_t)r * D_) + lane;
        float4 v[8]; float s = 0.f;
#pragma unroll
        for (int j = 0; j < 8; ++j) { v[j] = xr[64 * j]; s += (v[j].x + v[j].y) + (v[j].z + v[j].w); }
#pragma unroll
        for (int o = 1; o < 64; o <<= 1) s += __shfl_xor(s, o);
        const float mean = s * (1.f / D_); float q = 0.f;
#pragma unroll
        for (int j = 0; j < 8; ++j) { v[j].x -= mean; v[j].y -= mean; v[j].z -= mean; v[j].w -= mean; q += (v[j].x * v[j].x + v[j].y * v[j].y) + (v[j].z * v[j].z + v[j].w * v[j].w); }
#pragma unroll
        for (int o = 1; o < 64; o <<= 1) q += __shfl_xor(q, o);
        const float rstd = rsqrtf(q * (1.f / D_) + 1e-5f);
#pragma unroll
        for (int j = 0; j < 8; ++j) { const float4 gg = ((const float4*)g)[lane + 64 * j], bb = ((const float4*)bta)[lane + 64 * j];
            xr[64 * j] = make_float4(v[j].x * rstd * gg.x + bb.x, v[j].y * rstd * gg.y + bb.y, v[j].z * rstd * gg.z + bb.z, v[j].w * rstd * gg.w + bb.w); }
    }
}

namespace pg8 {
#define PG8_LAS __attribute__((address_space(3)))
typedef unsigned short bf16_t;
typedef short bf16x8 __attribute__((ext_vector_type(8)));
typedef float f32x4 __attribute__((ext_vector_type(4)));
typedef unsigned u32x4 __attribute__((ext_vector_type(4)));
constexpr int BM = 256, BK = 64, HALF = 128, HTB = HALF * BK * 2  , STAGE_BYTES = 8 * HTB, NXCD = 8, WGM = 8;

__host__ __device__ __forceinline__ int lds_byte(int r, int c) { const int st = (r >> 4) * 2 + (c >> 5), rr = r & 15, cc = c & 31, ob = rr * 64 + cc * 2; return st * 1024 + (ob ^ (((ob >> 9) & 1) << 5)); }
__host__ __device__ __forceinline__ void stage_rc(int b, int& R, int& C) { const int st = b / 1024, sb = b % 1024, swz = sb ^ (((sb >> 9) & 1) << 5); R = (st >> 1) * 16 + swz / 64; C = (st & 1) * 32 + (swz % 64) / 2; }
__host__ __device__ __forceinline__ int perm32(int rho) { const int n = rho >> 4, i = rho & 15; return 8 * (i >> 2) + 4 * n + (i & 3); }

struct Unit { int pm, pn; };
struct Gemm { const bf16_t* A; const bf16_t* Bt; int M, N, K; };

struct StaticOrder {
    int nM, nN, nwg, G, c;
    __host__ __device__ void init(int M, int N, int G_, int c_) { nM = M / BM; nN = N / BM; nwg = nM * nN; G = G_; c = c_; }
    __host__ __device__ bool next(int i, Unit& u) const {
        const long L = (long)i * G + c; if (L >= nwg) return false;
        int wgid = (int)L; { const int q = nwg / NXCD, r = nwg % NXCD, xcd = wgid % NXCD, off = wgid / NXCD; wgid = (xcd < r ? xcd * (q + 1) : r * (q + 1) + (xcd - r) * q) + off; }
        const int nig = WGM * nN, gid = wgid / nig, fm = gid * WGM, gsz = (nM - fm) < WGM ? (nM - fm) : WGM;
        u.pm = fm + ((wgid % nig) % gsz); u.pn = (wgid % nig) / gsz; return true;
    }
    __device__ __forceinline__ void a_ready(const Unit&) const {}
    __device__ __forceinline__ void done(const Unit&) const {}
};

__device__ __forceinline__ unsigned cvt_pk_bf16(float lo, float hi) { unsigned r; asm volatile("v_cvt_pk_bf16_f32 %0, %1, %2" : "=v"(r) : "v"(lo), "v"(hi)); return r; }
__device__ __forceinline__ float fast_sigmoid(float v) { return __builtin_amdgcn_rcpf(1.f + __builtin_amdgcn_exp2f(-1.4426950408889634f * v)); }
__device__ __forceinline__ f32x4 act4(f32x4 v, int act) {
    if (act == 0) return v;
    f32x4 s; s[0] = fast_sigmoid(v[0]); s[1] = fast_sigmoid(v[1]); s[2] = fast_sigmoid(v[2]); s[3] = fast_sigmoid(v[3]);
    return act == 1 ? v * s : s;
}
struct EpiH1 {
    static constexpr bool PERM = true, AFTER_DRAIN = false;
    bf16_t* HB; float* LOGF; float* NGATE; const float* b_f;
    __device__ __forceinline__ void operator()(const f32x4 (&acc)[2][2][4][2], const Unit& u, int wr, int wc, int fr, int fq) const {
        const int row0 = u.pm * BM + wr * 64 + fr;
        if (u.pn < 46) {
            const int act = ((u.pn >= 12 && u.pn < 16) || (u.pn >= 26 && u.pn < 30)) ? 1 : (u.pn >= 30 ? 2 : 0);
            const int col0 = u.pn * BM + wc * 32 + 8 * fq;
#pragma unroll
            for (int ai = 0; ai < 2; ++ai)
#pragma unroll
                for (int m = 0; m < 4; ++m) { bf16_t* rowp = HB + (size_t)(row0 + ai * HALF + m * 16) * 11776 + col0;
#pragma unroll
                    for (int bj = 0; bj < 2; ++bj) { const f32x4 v0 = act4(acc[ai][bj][m][0], act), v1 = act4(acc[ai][bj][m][1], act);
                        u32x4 w; w.x = cvt_pk_bf16(v0[0], v0[1]); w.y = cvt_pk_bf16(v0[2], v0[3]); w.z = cvt_pk_bf16(v1[0], v1[1]); w.w = cvt_pk_bf16(v1[2], v1[3]);
                        *(u32x4*)(rowp + bj * HALF) = w; } }
        } else if (wc == 0) {
#pragma unroll
            for (int ai = 0; ai < 2; ++ai)
#pragma unroll
                for (int m = 0; m < 4; ++m) { const size_t row = (size_t)(row0 + ai * HALF + m * 16);
#pragma unroll
                    for (int n = 0; n < 2; ++n) { const f32x4 v = acc[ai][0][m][n];
                        if (fq == 0) { f32x4 o;
#pragma unroll
                            for (int e = 0; e < 4; ++e) { const float t = v[e] + b_f[4 * n + e]; o[e] = fminf(t, 0.f) - 0.6931471805599453f * __builtin_amdgcn_logf(1.f + __builtin_amdgcn_exp2f(-1.4426950408889634f * fabsf(t))); }
                            *(f32x4*)(LOGF + row * 8 + 4 * n) = o; }
                        else { f32x4 o;
#pragma unroll
                            for (int e = 0; e < 4; ++e) o[e] = fast_sigmoid(v[e]);
                            *(f32x4*)(NGATE + row * 24 + 8 * fq + 4 * n - 8) = o; } } }
        }
    }
};
struct EpiMerge {
    static constexpr bool PERM = true, AFTER_DRAIN = false;
    const bf16_t* HB; u32x4* T1; bf16_t* MRG;
    __device__ __forceinline__ void operator()(const f32x4 (&acc)[2][2][4][2], const Unit& u, int wr, int wc, int fr, int fq) const {
        const int pass = u.pm >> 5, pm = u.pm & 31, pn = u.pn & 7;
        const int row0 = pm * BM + wr * 64 + fr, col0 = pn * BM + wc * 32 + 8 * fq;
        u32x4* t1 = T1 + (size_t)(pm * 8 + pn) * (16 * 512) + (wr * 4 + wc) * 64 + fq * 16 + fr;
        const int gcol = (pass ? 9728 : 7680) + col0;
#pragma unroll
        for (int ai = 0; ai < 2; ++ai)
#pragma unroll
            for (int m = 0; m < 4; ++m) { const size_t row = (size_t)(row0 + ai * HALF + m * 16);
#pragma unroll
                for (int bj = 0; bj < 2; ++bj) {
                    const u32x4 gw = *(const u32x4*)(HB + row * 11776 + gcol + bj * HALF);
                    f32x4 g0, g1; g0[0] = __uint_as_float(gw.x << 16); g0[1] = __uint_as_float(gw.x & 0xffff0000u); g0[2] = __uint_as_float(gw.y << 16); g0[3] = __uint_as_float(gw.y & 0xffff0000u);
                    g1[0] = __uint_as_float(gw.z << 16); g1[1] = __uint_as_float(gw.z & 0xffff0000u); g1[2] = __uint_as_float(gw.w << 16); g1[3] = __uint_as_float(gw.w & 0xffff0000u);
                    f32x4 v0 = acc[ai][bj][m][0] * g0, v1 = acc[ai][bj][m][1] * g1;
                    u32x4* tp = t1 + (size_t)((ai * 4 + m) * 2 + bj) * 512;
                    if (pass) { const u32x4 tw = *tp;
                        v0[0] += __uint_as_float(tw.x << 16); v0[1] += __uint_as_float(tw.x & 0xffff0000u); v0[2] += __uint_as_float(tw.y << 16); v0[3] += __uint_as_float(tw.y & 0xffff0000u);
                        v1[0] += __uint_as_float(tw.z << 16); v1[1] += __uint_as_float(tw.z & 0xffff0000u); v1[2] += __uint_as_float(tw.w << 16); v1[3] += __uint_as_float(tw.w & 0xffff0000u); }
                    u32x4 w; w.x = cvt_pk_bf16(v0[0], v0[1]); w.y = cvt_pk_bf16(v0[2], v0[3]); w.z = cvt_pk_bf16(v1[0], v1[1]); w.w = cvt_pk_bf16(v1[2], v1[3]);
                    if (pass) *(u32x4*)(MRG + row * 2048 + col0 + bj * HALF) = w; else *tp = w; } }
    }
};
struct PairOrder {
    int G, c;
    __device__ __forceinline__ bool next(int i, Unit& u) const {
        StaticOrder s; s.init(8192, 2048, G, c);
        if (!s.next(i >> 1, u)) return false;
        const int pass = i & 1; u.pm += 32 * pass; u.pn += 8 * pass; return true;
    }
    __device__ __forceinline__ void a_ready(const Unit&) const {}
    __device__ __forceinline__ void done(const Unit&) const {}
};
struct EpiRes5 {
    static constexpr bool PERM = false, AFTER_DRAIN = false;
    const float* X; float* O;
    __device__ __forceinline__ void operator()(const f32x4 (&acc)[2][2][4][2], const Unit& u, int wr, int wc, int fr, int fq) const {
        const int row0 = u.pm * BM + wr * 64 + fr, col0 = u.pn * BM + wc * 32 + 4 * fq;
#pragma unroll
        for (int ai = 0; ai < 2; ++ai)
#pragma unroll
            for (int m = 0; m < 4; ++m) { const size_t off = (size_t)(row0 + ai * HALF + m * 16) * 2048 + col0;
#pragma unroll
                for (int bj = 0; bj < 2; ++bj)
#pragma unroll
                    for (int n = 0; n < 2; ++n) { const f32x4 xv = *(const f32x4*)(X + off + bj * HALF + n * 16);
                        *(f32x4*)(O + off + bj * HALF + n * 16) = xv * 1.189207115002721f + acc[ai][bj][m][n]; } }
    }
};
template <class Epi, class Sched, bool ALIGN_EPI = false, bool SP2 = false>
__device__ __forceinline__ void gemm_phase(int wv, PG8_LAS unsigned char* lds, const Gemm g, const Sched& S, const Epi& E) {
    int tid_ = tid_fresh(wv);
    const int tid = tid_, wid = wv, lane = tid & 63, wr = wid >> 2, wc = wid & 3, fr = lane & 15, fq = lane >> 4;
    const int K = g.K, nt = K / BK;
    unsigned voffA[2], voffB[2];
#pragma unroll
    for (int i = 0; i < 2; ++i) { int R, C; stage_rc(tid * 16 + i * 8192, R, C); const int Rb = Epi::PERM ? ((R & ~31) + perm32(R & 31)) : R;
        voffA[i] = (unsigned)(R * K + C) * 2u; voffB[i] = (unsigned)(Rb * K + C) * 2u; }
    const size_t kstep = (size_t)(BK * 2);
    const size_t hstep = (size_t)HALF * K * 2;
    const size_t tstep = 2 * hstep;
    const unsigned ldsw = (unsigned)wid * 1024u;
    const int aoff = lds_byte(wr * 64 + fr, fq * 8), boff = lds_byte(wc * 32 + fr, fq * 8);
#define PG8_SA(b, h) (((b) * 2 + (h)) * HTB)
#define PG8_SB(b, h) ((4 + (b) * 2 + (h)) * HTB)
#define PG8_STAGE(bufoff, gbase, voff) do { _Pragma("unroll") for (int _i = 0; _i < 2; ++_i) \
        __builtin_amdgcn_global_load_lds((const unsigned*)((const char*)(gbase) + (voff)[_i]), (PG8_LAS unsigned*)(lds + (bufoff) + ldsw + _i * 8192), 16, 0, 0); } while (0)
#define PG8_LDA(dst, b, h) do { _Pragma("unroll") for (int m = 0; m < 4; ++m) _Pragma("unroll") for (int k = 0; k < 2; ++k) dst[m][k] = *(const PG8_LAS bf16x8*)(lds + PG8_SA(b, h) + aoff + m * 2048 + k * 1024); } while (0)
#define PG8_LDB(dst, b, h) do { _Pragma("unroll") for (int n = 0; n < 2; ++n) _Pragma("unroll") for (int k = 0; k < 2; ++k) dst[n][k] = *(const PG8_LAS bf16x8*)(lds + PG8_SB(b, h) + boff + n * 2048 + k * 1024); } while (0)
#define PG8_MMA(ai, bj, At, Bt) do { __builtin_amdgcn_s_setprio(1); _Pragma("unroll") for (int m = 0; m < 4; ++m) _Pragma("unroll") for (int n = 0; n < 2; ++n) _Pragma("unroll") for (int k = 0; k < 2; ++k) \
        acc[ai][bj][m][n] = __builtin_amdgcn_mfma_f32_16x16x32_bf16(Bt[n][k], At[m][k], acc[ai][bj][m][n], 0, 0, 0); __builtin_amdgcn_s_setprio(0); } while (0)
#define PG8_WAIT_V(n) asm volatile("s_waitcnt vmcnt(" #n ")" ::: "memory")
#define PG8_WAIT_L(n) asm volatile("s_waitcnt lgkmcnt(" #n ")" ::: "memory")
#define PG8_BAR __builtin_amdgcn_s_barrier()
#define PG8_SCHED __builtin_amdgcn_sched_barrier(0)
    Unit cur, nxt; int ui = 0;
    if (!S.next(0, cur)) return;
    f32x4 acc[2][2][4][2];
#pragma unroll
    for (int a = 0; a < 2; ++a)
#pragma unroll
        for (int b = 0; b < 2; ++b)
#pragma unroll
            for (int m = 0; m < 4; ++m)
#pragma unroll
                for (int n = 0; n < 2; ++n) acc[a][b][m][n] = (f32x4){0.f, 0.f, 0.f, 0.f};
    bf16x8 At[4][2], B0[2][2], B1[2][2];
    const char* cA = (const char*)g.A + (size_t)cur.pm * tstep; const char* cB = (const char*)g.Bt + (size_t)cur.pn * tstep;
    S.a_ready(cur);
    if constexpr (SP2) {
        PG8_STAGE(PG8_SB(0, 0), cB, voffB); PG8_STAGE(PG8_SB(0, 1), cB + hstep, voffB); PG8_STAGE(PG8_SA(0, 0), cA, voffA); PG8_STAGE(PG8_SA(0, 1), cA + hstep, voffA);
        if (wr == 1) PG8_BAR;
        PG8_WAIT_V(2); PG8_BAR;
        PG8_STAGE(PG8_SB(1, 0), cB + kstep, voffB); PG8_STAGE(PG8_SA(1, 0), cA + kstep, voffA); PG8_STAGE(PG8_SB(1, 1), cB + hstep + kstep, voffB);
        PG8_WAIT_V(6); PG8_BAR;
    } else {
        PG8_STAGE(PG8_SB(0, 0), cB, voffB); PG8_STAGE(PG8_SA(0, 0), cA, voffA); PG8_STAGE(PG8_SB(0, 1), cB + hstep, voffB); PG8_STAGE(PG8_SA(0, 1), cA + hstep, voffA);
        if (wr == 1) PG8_BAR;
        PG8_WAIT_V(4); PG8_BAR;
        PG8_STAGE(PG8_SB(1, 0), cB + kstep, voffB); PG8_STAGE(PG8_SA(1, 0), cA + kstep, voffA); PG8_STAGE(PG8_SB(1, 1), cB + hstep + kstep, voffB);
        PG8_WAIT_V(6); PG8_BAR;
    }
    for (;;) {
        const bool has_next = S.next(ui + 1, nxt);
        const char* nA = has_next ? (const char*)g.A + (size_t)nxt.pm * tstep : cA; const char* nB = has_next ? (const char*)g.Bt + (size_t)nxt.pn * tstep : cB;
        for (int t = 0; t < nt; t += 2) {
            const bool last = (t == nt - 2);
            const char* a1 = cA + (size_t)(t + 1) * kstep;
            const char* a2 = last ? nA : cA + (size_t)(t + 2) * kstep; const char* b2 = last ? nB : cB + (size_t)(t + 2) * kstep;
            const char* a3 = a2 + kstep; const char* b3 = b2 + kstep;
            if (last && has_next) S.a_ready(nxt);
            if constexpr (SP2) {
            PG8_LDB(B0, 0, 0); PG8_LDB(B1, 0, 1); PG8_SCHED; PG8_LDA(At, 0, 0); PG8_STAGE(PG8_SA(1, 1), a1 + hstep, voffA);
            PG8_WAIT_V(8); PG8_WAIT_L(0); PG8_BAR; PG8_MMA(0, 0, At, B0); PG8_MMA(0, 1, At, B1); PG8_BAR; PG8_SCHED;
            PG8_LDA(At, 0, 1); PG8_STAGE(PG8_SB(0, 0), b2, voffB); PG8_STAGE(PG8_SB(0, 1), b2 + hstep, voffB); PG8_STAGE(PG8_SA(0, 0), a2, voffA);
            PG8_WAIT_V(8); PG8_WAIT_L(0); PG8_BAR; PG8_MMA(1, 0, At, B0); PG8_MMA(1, 1, At, B1); PG8_BAR; PG8_SCHED;
            PG8_LDB(B0, 1, 0); PG8_LDB(B1, 1, 1); PG8_SCHED; PG8_LDA(At, 1, 0); PG8_STAGE(PG8_SA(0, 1), a2 + hstep, voffA);
            PG8_WAIT_V(8); PG8_WAIT_L(0); PG8_BAR; PG8_MMA(0, 0, At, B0); PG8_MMA(0, 1, At, B1); PG8_BAR; PG8_SCHED;
            PG8_LDA(At, 1, 1); PG8_STAGE(PG8_SB(1, 0), b3, voffB); PG8_STAGE(PG8_SB(1, 1), b3 + hstep, voffB); PG8_STAGE(PG8_SA(1, 0), a3, voffA);
            PG8_WAIT_V(8); PG8_WAIT_L(0); PG8_BAR; PG8_MMA(1, 0, At, B0); PG8_MMA(1, 1, At, B1); PG8_BAR; PG8_SCHED;
            } else {
            PG8_LDB(B0, 0, 0); PG8_SCHED; PG8_LDA(At, 0, 0); PG8_STAGE(PG8_SA(1, 1), a1 + hstep, voffA);
            PG8_WAIT_L(8); PG8_BAR; PG8_WAIT_L(0); PG8_MMA(0, 0, At, B0); PG8_BAR; PG8_SCHED;
            PG8_LDB(B1, 0, 1); PG8_STAGE(PG8_SB(0, 0), b2, voffB);
            PG8_BAR; PG8_WAIT_L(0); PG8_MMA(0, 1, At, B1); PG8_BAR;
            PG8_LDA(At, 0, 1); PG8_STAGE(PG8_SA(0, 0), a2, voffA);
            PG8_BAR; PG8_WAIT_L(0); PG8_MMA(1, 0, At, B0); PG8_BAR; PG8_SCHED;
            PG8_STAGE(PG8_SB(0, 1), b2 + hstep, voffB);
            PG8_WAIT_V(6); PG8_BAR; PG8_MMA(1, 1, At, B1); PG8_BAR;
            PG8_LDB(B0, 1, 0); PG8_SCHED; PG8_LDA(At, 1, 0); PG8_STAGE(PG8_SA(0, 1), a2 + hstep, voffA);
            PG8_WAIT_L(8); PG8_BAR; PG8_WAIT_L(0); PG8_MMA(0, 0, At, B0); PG8_BAR; PG8_SCHED;
            PG8_LDB(B1, 1, 1); PG8_STAGE(PG8_SB(1, 0), b3, voffB);
            PG8_BAR; PG8_WAIT_L(0); PG8_MMA(0, 1, At, B1); PG8_BAR;
            PG8_LDA(At, 1, 1); PG8_STAGE(PG8_SA(1, 0), a3, voffA);
            PG8_BAR; PG8_WAIT_L(0); PG8_MMA(1, 0, At, B0); PG8_BAR; PG8_SCHED;
            PG8_STAGE(PG8_SB(1, 1), b3 + hstep, voffB);
            PG8_WAIT_V(6); PG8_BAR; PG8_MMA(1, 1, At, B1); PG8_BAR;
            }
        }
        if constexpr (ALIGN_EPI) { if (wr == 0) PG8_BAR; }
        if constexpr (!Epi::AFTER_DRAIN) { E(acc, cur, wr, wc, fr, fq); S.done(cur); }
        if (!has_next) break;
#pragma unroll
        for (int a = 0; a < 2; ++a)
#pragma unroll
            for (int b = 0; b < 2; ++b)
#pragma unroll
                for (int m = 0; m < 4; ++m)
#pragma unroll
                    for (int n = 0; n < 2; ++n) acc[a][b][m][n] = (f32x4){0.f, 0.f, 0.f, 0.f};
        cur = nxt; cA = nA; cB = nB; ++ui;
        if constexpr (ALIGN_EPI) { if (wr == 1) PG8_BAR; }
    }
    PG8_WAIT_V(0);
    if constexpr (!ALIGN_EPI) { if (wr == 0) PG8_BAR; }
    PG8_BAR;
    if constexpr (Epi::AFTER_DRAIN) { E.fused(acc, cur, wr, wc, fr, fq, lds, wid, lane); S.done(cur); }
#undef PG8_SA
#undef PG8_SB
#undef PG8_STAGE
#undef PG8_LDA
#undef PG8_LDB
#undef PG8_MMA
#undef PG8_WAIT_V
#undef PG8_WAIT_L
#undef PG8_BAR
#undef PG8_SCHED
}
}
__device__ __forceinline__ unsigned pk2(float lo, float hi) { return (unsigned)f2bf(lo) | ((unsigned)f2bf(hi) << 16); }
template <class CS>
__device__ __forceinline__ void transpose_item(const float* __restrict__ W, int K, int ldw, bf16_t* __restrict__ WT, int drow0, int k0, float* scr, int lane, const CS& csrc) {
    const int j = lane & 31; const int sc = csrc(j);
    float v[32];
    const float* wp = W + (size_t)(k0 + (lane >> 5)) * ldw + (sc >= 0 ? sc : 0);
#pragma unroll
    for (int i = 0; i < 32; ++i) v[i] = wp[(size_t)(2 * i) * ldw];
#pragma unroll
    for (int i = 0; i < 32; ++i) scr[(2 * i + (lane >> 5)) * 33 + j] = sc >= 0 ? v[i] : 0.f;
    asm volatile("s_waitcnt lgkmcnt(0)" ::: "memory");
    const int c = lane & 7;
#pragma unroll
    for (int jj = 0; jj < 4; ++jj) { const int n = (lane >> 3) + 8 * jj; const float* s = scr + (8 * c) * 33 + n;
        uint4 o; o.x = pk2(s[0 * 33], s[1 * 33]); o.y = pk2(s[2 * 33], s[3 * 33]); o.z = pk2(s[4 * 33], s[5 * 33]); o.w = pk2(s[6 * 33], s[7 * 33]);
        *(uint4*)(WT + (size_t)(drow0 + n) * K + k0 + 8 * c) = o; }
    asm volatile("s_waitcnt lgkmcnt(0)" ::: "memory");
}
__device__ __forceinline__ void p0_phase(int wv, const Params& p, bf16_t* XB, bf16_t* WINT, bf16_t* WABT, bf16_t* WOT, bf16_t* W1T, bf16_t* W2T, float* POSW, unsigned char* lds) {
    const int tx = tid_fresh(wv); const int lane = tx & 63, wave = tx >> 6;
    float* scr = (float*)(lds + wave * 8704);
    const int gw = blockIdx.x * 8 + wave, NGW = gridDim.x * 8;
    constexpr int I_IN = 32 * 376, I_AB = 16 * 64, I_O = 32 * 64, I_1 = 64 * 8, I_2 = 4 * 4;
    for (int it = gw; it < I_IN + 2 * I_AB + I_O + 2 * I_1 + 2 * I_2; it += NGW) {
        int r = it;
        if (r < I_IN) { const int kb = r / 376, nb = r % 376, n0 = nb * 32;
            if (n0 < 11776) { const int s0 = n0 < 3072 ? n0 : (n0 < 6656 ? n0 + 8 : n0 + 32); transpose_item(p.in[1], 2048, INC, WINT, n0, kb * 64, scr, lane, [=](int j) { return s0 + j; }); }
            else if (n0 == 11776) transpose_item(p.in[1], 2048, INC, WINT, n0, kb * 64, scr, lane, [](int j) { return j < 8 ? 3072 + j : 6664 + (j - 8); });
            else transpose_item(p.in[1], 2048, INC, WINT, n0, kb * 64, scr, lane, [](int) { return -1; });
            continue; }
        r -= I_IN;
        if (r < I_AB) { const int kb = r / 64, n0 = (r % 64) * 32; transpose_item(p.in[9], 1024, 2048, WABT, n0, kb * 64, scr, lane, [=](int j) { return n0 + j; }); continue; }
        r -= I_AB;
        if (r < I_AB) { const int kb = r / 64, n0 = (r % 64) * 32; transpose_item(p.in[10], 1024, 2048, WABT, 2048 + n0, kb * 64, scr, lane, [=](int j) { return n0 + j; }); continue; }
        r -= I_AB;
        if (r < I_O) { const int kb = r / 64, n0 = (r % 64) * 32; transpose_item(p.in[11], 2048, 2048, WOT, n0, kb * 64, scr, lane, [=](int j) { return n0 + j; }); continue; }
        r -= I_O;
        if (r < 2 * I_1) { const int kv = r / I_1, q = r % I_1, kb = q / 8, n0 = (q % 8) * 32; transpose_item(kv ? p.in[7] : p.in[5], 4096, 256, W1T + (size_t)kv * 256 * 4096, n0, kb * 64, scr, lane, [=](int j) { return n0 + j; }); continue; }
        r -= 2 * I_1;
        { const int kv = r / I_2, q = r % I_2, kb = q / 4, n0 = (q % 4) * 32; transpose_item(kv ? p.in[8] : p.in[6], 256, 128, W2T + (size_t)kv * 128 * 256, n0, kb * 64, scr, lane, [=](int j) { return n0 + j; }); }
    }
    for (int o = gw; o < 512; o += NGW) { const int kv = o >> 8, n = o & 255; const float* pos = kv ? p.in[4] : p.in[3]; const float* w1 = kv ? p.in[7] : p.in[5];
        float a = 0.f;
        for (int kk = lane; kk < 4096; kk += 64) a += pos[kk] * w1[(size_t)kk * 256 + n];
#pragma unroll
        for (int sft = 32; sft > 0; sft >>= 1) a += __shfl_xor(a, sft);
        if (lane == 0) POSW[o] = a; }
    const float* x = p.in[0];
    for (size_t i0 = ((size_t)blockIdx.x * NTHREADS + tx) * 8; i0 < (size_t)M_ * D_; i0 += (size_t)gridDim.x * NTHREADS * 8 * 4) {
        float4 a[4], b[4];
#pragma unroll
        for (int u = 0; u < 4; ++u) { const size_t i = i0 + (size_t)u * gridDim.x * NTHREADS * 8; a[u] = *(const float4*)(x + i); b[u] = *(const float4*)(x + i + 4); }
#pragma unroll
        for (int u = 0; u < 4; ++u) { const size_t i = i0 + (size_t)u * gridDim.x * NTHREADS * 8;
            uint4 o; o.x = pk2(a[u].x, a[u].y); o.y = pk2(a[u].z, a[u].w); o.z = pk2(b[u].x, b[u].y); o.w = pk2(b[u].z, b[u].w);
            *(uint4*)(XB + i) = o; }
    }
}

__device__ __forceinline__ void compress_hidden_phase(int wv, const bf16_t* __restrict__ HB, const bf16_t* __restrict__ W1T, const float* __restrict__ POSW, bf16_t* __restrict__ HID, unsigned char* lds) {
    typedef short bf16x8 __attribute__((ext_vector_type(8)));
    typedef float f32x16 __attribute__((ext_vector_type(16)));
    typedef float f32x4 __attribute__((ext_vector_type(4)));
    const int tid = tid_fresh(wv), lane = tid & 63, r32 = lane & 31, hi = lane >> 5, wid = wv;
    PG8_LAS float* red = (PG8_LAS float*)(PG8_LAS unsigned char*)lds;
    for (int u = blockIdx.x; u < 256; u += gridDim.x) {
        const int kv = u & 1, g = (u >> 1) & 1, ct = (u >> 2) & 3, nq = (u >> 4) & 3, b = u >> 6;
        const int cl = min(ct * 32 + r32, NCMP - 1);
        const bf16_t* Ap = HB + (size_t)(b * S_ + 16 * cl + 4 * wid) * PITCH + (kv ? H_VC : H_KC) + g * 128 + 8 * hi;
        const bf16_t* Bp = W1T + (size_t)kv * 256 * 4096 + (size_t)(nq * 64 + r32) * 4096 + (4 * wid) * 128 + 8 * hi;
        f32x16 acc0 = {}, acc1 = {};
#pragma unroll
        for (int l = 0; l < 4; ++l) {
            bf16x8 a[8], b0[8], b1[8];
#pragma unroll
            for (int j = 0; j < 8; ++j) { a[j] = *(const bf16x8*)(Ap + (size_t)l * PITCH + j * 16); b0[j] = *(const bf16x8*)(Bp + l * 128 + j * 16); b1[j] = *(const bf16x8*)(Bp + (size_t)32 * 4096 + l * 128 + j * 16); }
#pragma unroll
            for (int j = 0; j < 8; ++j) { acc0 = __builtin_amdgcn_mfma_f32_32x32x16_bf16(a[j], b0[j], acc0, 0, 0, 0); acc1 = __builtin_amdgcn_mfma_f32_32x32x16_bf16(a[j], b1[j], acc1, 0, 0, 0); }
        }
#pragma unroll
        for (int r = 0; r < 16; ++r) { red[((wid * 2 + 0) * 16 + r) * 64 + lane] = acc0[r]; red[((wid * 2 + 1) * 16 + r) * 64 + lane] = acc1[r]; }
        __syncthreads();
#pragma unroll
        for (int i = 0; i < 4; ++i) { const int e = tid + 512 * i, t = e >> 10, r = (e >> 6) & 15, ln = e & 63;
            float s = 0.f;
#pragma unroll
            for (int w = 0; w < 8; ++w) s += red[w * 2048 + e];
            const int row = (r & 3) + 8 * (r >> 2) + 4 * (ln >> 5), n = nq * 64 + t * 32 + (ln & 31);
            const float v = s + POSW[kv * 256 + n]; const float uu = 1.5957691216057308f * (v + 0.044715f * v * v * v);
            const float gl = v * __builtin_amdgcn_rcpf(1.f + __builtin_amdgcn_exp2f(-1.4426950408889634f * uu));
            HID[((size_t)((kv * 4 + b) * 2 + g) * 128 + ct * 32 + row) * 256 + n] = f2bf(gl); }
        __syncthreads();
    }
}
__device__ __forceinline__ void compress_out_phase(int wv, const bf16_t* __restrict__ HID, const bf16_t* __restrict__ W2T, bf16_t* __restrict__ KCMP, bf16_t* __restrict__ VCMP) {
    typedef short bf16x8 __attribute__((ext_vector_type(8)));
    typedef float f32x16 __attribute__((ext_vector_type(16)));
    const int tid = tid_fresh(wv), lane = tid & 63, r32 = lane & 31, hi = lane >> 5, wid = wv;
    if (wid >= 4) return;
    for (int u = blockIdx.x; u < 64; u += gridDim.x) {
        const int kv = u & 1, g = (u >> 1) & 1, ct = (u >> 2) & 3, b = u >> 4;
        const bf16_t* A2 = HID + ((size_t)((kv * 4 + b) * 2 + g) * 128 + ct * 32 + r32) * 256 + 8 * hi;
        const bf16_t* B2 = W2T + (size_t)kv * 128 * 256 + (size_t)(wid * 32 + r32) * 256 + 8 * hi;
        f32x16 acc2 = {};
#pragma unroll
        for (int ks = 0; ks < 16; ++ks) acc2 = __builtin_amdgcn_mfma_f32_32x32x16_bf16(*(const bf16x8*)(A2 + ks * 16), *(const bf16x8*)(B2 + ks * 16), acc2, 0, 0, 0);
        bf16_t* out = (kv ? VCMP : KCMP) + (size_t)((b * 2 + g) * 128 + ct * 32) * 128 + wid * 32 + r32;
#pragma unroll
        for (int r = 0; r < 16; ++r) { const int row = (r & 3) + 8 * (r >> 2) + 4 * hi; out[(size_t)row * 128] = (ct * 32 + row < NCMP) ? f2bf(acc2[r]) : (bf16_t)0; }
    }
}

namespace att {
#define LAS __attribute__((address_space(3)))
typedef short bf16x8 __attribute__((ext_vector_type(8)));
typedef short s16x4 __attribute__((ext_vector_type(4)));
typedef float f32x16 __attribute__((ext_vector_type(16)));
typedef float f32x4 __attribute__((ext_vector_type(4)));
typedef unsigned u32x4 __attribute__((ext_vector_type(4)));
constexpr int QBLK = 32, KVBLK = 64;
constexpr int SHM_V = 16384, SHM_K = 16384;
constexpr int L_V = 0, L_K = 2 * SHM_V, L_WS = 65536, L_CN = L_WS + 2048, L_LUT = L_CN + 2048, L_IMPH = L_LUT + 4096, L_IMP2 = L_IMPH + 4 * 64 * 33 * 4, L_SELM = L_IMP2 + 64 * 33 * 4, L_QW = L_SELM + 256, L_END = L_QW + 64;
static_assert(L_END <= 131072, "attention LDS map");
constexpr float THR = 8.f;
constexpr float NEGINF = -__builtin_inff();

#define KSWZ(row, colB) ((row) * 256 + ((colB) ^ (((row) & 7) << 4)))
#define SBAR() __builtin_amdgcn_sched_barrier(0)
__device__ __forceinline__ int v_st(int k, int c) { const int kk = (k & ~0xC) | ((k & 4) << 1) | ((k & 8) >> 1); return ((kk >> 3) * 4 + (c >> 5)) * 512 + ((kk & 7) * 32 + (c & 31)) * 2; }
__device__ __forceinline__ int v_rd_base(int lane) { return ((lane & 3) << 3) | (((lane >> 2) & 3) << 6) | (((lane >> 4) & 1) << 5) | (((lane >> 5) & 1) << 8); }
constexpr int v_rd_off(int d0, int ks, int half) { return d0 * 512 + ks * 4096 + half * 2048; }
__device__ __forceinline__ int crow(int r, int hi) { return (r & 3) + 8 * (r >> 2) + 4 * hi; }
__device__ __forceinline__ unsigned cvtpk(float lo, float hi) { unsigned r; asm volatile("v_cvt_pk_bf16_f32 %0, %1, %2" : "=v"(r) : "v"(lo), "v"(hi)); return r; }

__device__ __forceinline__ void partialSM(f32x16& p0, f32x16& p1, float& m_reg, float& mn, float& alpha) {
    float pmax = p0[0];
#pragma unroll
    for (int r = 1; r < 16; ++r) pmax = fmaxf(pmax, p0[r]);
#pragma unroll
    for (int r = 0; r < 16; ++r) pmax = fmaxf(pmax, p1[r]);
    { auto rr = __builtin_amdgcn_permlane32_swap(__float_as_uint(pmax), __float_as_uint(pmax), false, false);
      pmax = fmaxf(__uint_as_float(rr[0]), __uint_as_float(rr[1])); }
    constexpr float C2 = 1.4426950408889634f * SCALE;
    if (__builtin_expect(__all((pmax - m_reg) * SCALE <= THR), 1)) { mn = m_reg; alpha = 1.f; }
    else { mn = fmaxf(m_reg, pmax); alpha = __builtin_amdgcn_exp2f((m_reg - mn) * C2); m_reg = mn; }
    const float mnL = -mn * C2;
#pragma unroll
    for (int r = 0; r < 16; ++r) p0[r] = fmaf(p0[r], C2, mnL);
#pragma unroll
    for (int r = 0; r < 16; ++r) p1[r] = fmaf(p1[r], C2, mnL);
#pragma unroll
    for (int r = 0; r < 16; ++r) p0[r] = __builtin_amdgcn_exp2f(p0[r]);
}
#define PK4(P, B_, OUT) do { unsigned a0 = cvtpk(P[B_+0], P[B_+1]), a1 = cvtpk(P[B_+2], P[B_+3]);                          \
        unsigned b0 = cvtpk(P[B_+4], P[B_+5]), b1 = cvtpk(P[B_+6], P[B_+7]);                                             \
        auto r0 = __builtin_amdgcn_permlane32_swap(a0, b0, false, false); auto r1 = __builtin_amdgcn_permlane32_swap(a1, b1, false, false); \
        u32x4 w = {r0[0], r1[0], r0[1], r1[1]}; OUT = *reinterpret_cast<bf16x8*>(&w); } while (0)
__device__ __forceinline__ void finishSM(f32x16& p0, f32x16& p1, float alpha, float& l_reg, bf16x8& pa0, bf16x8& pa1, bf16x8& pa2, bf16x8& pa3) {
#pragma unroll
    for (int r = 0; r < 16; ++r) p1[r] = __builtin_amdgcn_exp2f(p1[r]);
    float ps = 0;
#pragma unroll
    for (int r = 0; r < 16; ++r) ps += p0[r];
#pragma unroll
    for (int r = 0; r < 16; ++r) ps += p1[r];
    { auto rr = __builtin_amdgcn_permlane32_swap(__float_as_uint(ps), __float_as_uint(ps), false, false);
      ps = __uint_as_float(rr[0]) + __uint_as_float(rr[1]); }
    l_reg = l_reg * alpha + ps;
    PK4(p0, 0, pa0); PK4(p0, 8, pa1); PK4(p1, 0, pa2); PK4(p1, 8, pa3);
}
template <int KB, bool BIAS>
__device__ __forceinline__ void qkt(f32x16& p0, f32x16& p1, const LAS char* K_lds, const LAS char* cnb, int r32, int hi, const bf16x8* qr, bool act) {
    if (!act) {
#pragma unroll
        for (int r = 0; r < 16; ++r) { p0[r] = NEGINF; p1[r] = NEGINF; }
        return; }
    if (BIAS) {
        const bf16x8 c0 = *(const LAS bf16x8*)(cnb + KB * 1024 + r32 * 16);
        const bf16x8 c1 = *(const LAS bf16x8*)(cnb + KB * 1024 + 512 + r32 * 16);
        const short one = hi ? (short)0 : (short)0x3F80;
        const bf16x8 q1 = {one, one, one, 0, 0, 0, 0, 0};
        p0 = __builtin_amdgcn_mfma_f32_32x32x16_bf16(c0, q1, p0, 0, 0, 0);
        p1 = __builtin_amdgcn_mfma_f32_32x32x16_bf16(c1, q1, p1, 0, 0, 0);
    }
    const LAS char* kb[4];
#pragma unroll
    for (int dd = 0; dd < 4; ++dd) kb[dd] = K_lds + KB * SHM_K + KSWZ(r32, (dd * 16 + hi * 8) * 2);
#pragma unroll
    for (int d0 = 0; d0 < 8; ++d0) { const LAS char* a = kb[d0 & 3] + (d0 >> 2) * 128;
        bf16x8 b0 = *(const LAS bf16x8*)(a);
        bf16x8 b1 = *(const LAS bf16x8*)(a + 32 * 256);
        p0 = __builtin_amdgcn_mfma_f32_32x32x16_bf16(b0, qr[d0], p0, 0, 0, 0);
        p1 = __builtin_amdgcn_mfma_f32_32x32x16_bf16(b1, qr[d0], p1, 0, 0, 0); }
}
template <int VB>
__device__ __forceinline__ void pv_tile(f32x16* o, int vb0, bf16x8 pa0, bf16x8 pa1, bf16x8 pa2, bf16x8 pa3, bool act) {
    if (!act) return;
#define TRRD(dst, off) asm volatile("ds_read_b64_tr_b16 %0, %1 offset:%2" : "=&v"(dst) : "v"(vb0), "i"(off) : "memory")
#define PV_D0(d0) do { s16x4 l0, l1, l2, l3, h0, h1, h2, h3; constexpr int b_ = VB * SHM_V + v_rd_off(d0, 0, 0); \
        TRRD(l0, b_); TRRD(h0, b_ + 2048); TRRD(l1, b_ + 4096); TRRD(h1, b_ + 6144); TRRD(l2, b_ + 8192); TRRD(h2, b_ + 10240); TRRD(l3, b_ + 12288); TRRD(h3, b_ + 14336); \
        asm volatile("s_waitcnt lgkmcnt(0)" ::: "memory"); SBAR();   \
        o[d0] = __builtin_amdgcn_mfma_f32_32x32x16_bf16(pa0, (bf16x8){l0[0], l0[1], l0[2], l0[3], h0[0], h0[1], h0[2], h0[3]}, o[d0], 0, 0, 0);   \
        o[d0] = __builtin_amdgcn_mfma_f32_32x32x16_bf16(pa1, (bf16x8){l1[0], l1[1], l1[2], l1[3], h1[0], h1[1], h1[2], h1[3]}, o[d0], 0, 0, 0);   \
        o[d0] = __builtin_amdgcn_mfma_f32_32x32x16_bf16(pa2, (bf16x8){l2[0], l2[1], l2[2], l2[3], h2[0], h2[1], h2[2], h2[3]}, o[d0], 0, 0, 0);   \
        o[d0] = __builtin_amdgcn_mfma_f32_32x32x16_bf16(pa3, (bf16x8){l3[0], l3[1], l3[2], l3[3], h3[0], h3[1], h3[2], h3[3]}, o[d0], 0, 0, 0); } while (0)
    PV_D0(0); PV_D0(1); PV_D0(2); PV_D0(3);
#undef PV_D0
#undef TRRD
}

__device__ __forceinline__ void init_lut(f32x16& p0, f32x16& p1, const LAS float* lut, int dq1  ) {
#pragma unroll
    for (int r = 0; r < 16; ++r) { const int c = (r & 3) + 8 * (r >> 2);
        p0[r] = lut[min(max(dq1 - c, 0), 114)]; p1[r] = lut[min(max(dq1 - c - 32, 0), 114)]; }
}
__device__ __forceinline__ void init_lut_cmp(f32x16& p0, f32x16& p1, const LAS float* lut, int dq1  ) {
#pragma unroll
    for (int r = 0; r < 16; ++r) { const int c = 16 * ((r & 3) + 8 * (r >> 2));
        p0[r] = lut[min(max(dq1 - c, 0), 114)]; p1[r] = lut[min(max(dq1 - c - 512, 0), 114)]; }
}
__device__ __forceinline__ void init_const(f32x16& p0, f32x16& p1, float v) {
#pragma unroll
    for (int r = 0; r < 16; ++r) { p0[r] = v; p1[r] = v; }
}
__device__ __forceinline__ void init_edge(f32x16& p0, f32x16& p1, int dq  , int W) {
#pragma unroll
    for (int r = 0; r < 16; ++r) { const int c = (r & 3) + 8 * (r >> 2);
        p0[r] = (dq - c) < W ? 0.f : NEGINF; p1[r] = (dq - c - 32) < W ? 0.f : NEGINF; }
}
__device__ __forceinline__ void init_causal(f32x16& p0, f32x16& p1, int dq  ) {
#pragma unroll
    for (int r = 0; r < 16; ++r) { const int c = (r & 3) + 8 * (r >> 2);
        p0[r] = (dq - c) < 0 ? NEGINF : 0.f; p1[r] = (dq - c - 32) < 0 ? NEGINF : 0.f; }
}

template <int MODE, int pitch>
__device__ __forceinline__ void attn_pass(int wv, const bf16_t* __restrict__ Kp, const bf16_t* __restrict__ Vp, const bf16_t* __restrict__ CNp, int j_lo, int NT,
                                          const bf16x8* qr, int tpos, int qlo, unsigned selbits, const LAS float* lut, LAS char* lds, f32x16* o, float& l_out) {
    const int tid_ = tid_fresh(wv);
    const int tid = tid_, wid = wv, lane = tid & 63, r32 = lane & 31, hi = lane >> 5;
    LAS char* V_lds = lds + L_V; LAS char* K_lds = lds + L_K;
    LAS float* ws = (LAS float*)(lds + L_WS) + wid * 64; LAS float* al_l = ws + 32;
    LAS char* cnb = lds + L_CN;
    const int sr = tid >> 4, sc = (tid & 15) * 8, vst0 = v_st(sr, sc), vst1 = v_st(32 + sr, sc), kws = KSWZ(sr, sc * 2);
    const int vb0 = (int)(size_t)V_lds + v_rd_base(lane);
    float m_reg = -1e30f, l_reg = 0.f;
#pragma unroll
    for (int d = 0; d < 4; ++d) o[d] = f32x16{};
    bf16x8 st_v0, st_v1, st_k0, st_k1, st_cn;
#define KBASE(t) ((j_lo + (t)) * KVBLK)
#define ROWP(p, k0, rr) ((p) + (size_t)((k0) + (rr)) * pitch + sc)
#define VMW() asm volatile("s_waitcnt vmcnt(0)" ::: "memory")
#define SLOAD(t) do { const int k0_ = KBASE(t); st_v0 = *(const bf16x8*)ROWP(Vp, k0_, sr); st_v1 = *(const bf16x8*)ROWP(Vp, k0_, 32 + sr);              \
                      st_k0 = *(const bf16x8*)ROWP(Kp, k0_, sr); st_k1 = *(const bf16x8*)ROWP(Kp, k0_, 32 + sr);                                          \
                      if (MODE == 0) { if (tid < 64) st_cn = *(const bf16x8*)(CNp + (size_t)(k0_ + tid) * 8); } } while (0)
#define SWRITE(bf) do { *(LAS bf16x8*)(V_lds + (bf) * SHM_V + vst0) = st_v0; *(LAS bf16x8*)(V_lds + (bf) * SHM_V + vst1) = st_v1;                                 \
                        *(LAS bf16x8*)(K_lds + (bf) * SHM_K + kws) = st_k0; *(LAS bf16x8*)(K_lds + (bf) * SHM_K + kws + 32 * 256) = st_k1;                        \
                        if (MODE == 0) { if (tid < 64) *(LAS bf16x8*)(cnb + (bf) * 1024 + tid * 16) = st_cn; } } while (0)
#define RESC(a) do { if (__any((a) < 1.f)) { if (hi == 0) al_l[r32] = (a); asm volatile("s_waitcnt lgkmcnt(0)" ::: "memory");              \
                     _Pragma("unroll") for (int d_ = 0; d_ < 4; ++d_) _Pragma("unroll") for (int r = 0; r < 16; ++r) o[d_][r] *= al_l[crow(r, hi)]; } } while (0)
#define SELB(t) ((selbits >> (j_lo + (t))) & 1u)
#define ACT(t) (MODE == 2 ? (bool)__any(SELB(t)) : (MODE == 3 ? true : (KBASE(t) <= qlo + QBLK - 1)))
#define INIT(P0, P1, t, KB) do { const int kb_ = KBASE(t);                                                                                   \
        if (MODE == 0) { if (kb_ + KVBLK - 1 > qlo) init_causal(P0, P1, tpos - kb_ - 4 * hi); else init_const(P0, P1, 0.f); }                     \
        else { const bool near_ = kb_ + KVBLK - 1 > qlo - 113;                                                                                \
               if (near_) init_lut(P0, P1, lut, tpos - kb_ - 4 * hi + 1);                                                                    \
               else if (MODE == 3 && kb_ <= qlo + QBLK - 1 - 512) init_edge(P0, P1, tpos - kb_ - 4 * hi, 512);                                \
               else init_const(P0, P1, 0.f);                                                                                                 \
               if (MODE == 2) { if (!SELB(t)) init_const(P0, P1, NEGINF); } } } while (0)
    f32x16 p0, p1; float mn, al; bf16x8 pa0, pa1, pa2, pa3;
    SLOAD(0);
    __syncthreads();
    VMW(); SWRITE(0);
    __syncthreads();
#define STEP(t, BUF) do {                                                                                                     \
        if ((t) + 1 < NT) { SLOAD((t) + 1); }                                                                                  \
        SBAR(); INIT(p0, p1, t, BUF); qkt<BUF, MODE == 0>(p0, p1, K_lds, cnb, r32, hi, qr, ACT(t));                            \
        partialSM(p0, p1, m_reg, mn, al); RESC(al);                                                                            \
        finishSM(p0, p1, al, l_reg, pa0, pa1, pa2, pa3); SBAR();                                                               \
        pv_tile<BUF>(o, vb0, pa0, pa1, pa2, pa3, ACT(t));                                                                      \
        if ((t) + 1 < NT) { VMW(); SWRITE((BUF) ^ 1); }                                                                        \
        __syncthreads(); } while (0)
    int t = 0;
    for (; t + 1 < NT; t += 2) { STEP(t, 0); STEP(t + 1, 1); }
    if (t < NT) STEP(t, 0);
#undef STEP
    l_out = l_reg;
#undef KBASE
#undef ROWP
#undef SLOAD
#undef SWRITE
#undef RESC
#undef SELB
#undef ACT
#undef INIT
}

__device__ __forceinline__ void store_rows(const f32x16* o, const LAS float* rs, LAS bf16_t* stg, bf16_t* Orow0, size_t opitch, const bf16_t* Zrow0, size_t zpitch, int lane) {
    asm volatile("" : "+v"(lane));
    const int r32 = lane & 31, hi = lane >> 5;
#pragma unroll
    for (int r = 0; r < 16; ++r) { const int orow = crow(r, hi); const float s = rs[orow];
#pragma unroll
        for (int d0 = 0; d0 < 4; ++d0) stg[orow * 128 + d0 * 32 + r32] = f2bf(o[d0][r] * s); }
    asm volatile("s_waitcnt lgkmcnt(0)" ::: "memory");
#pragma unroll
    for (int i = 0; i < 8; ++i) { const int row = i * 4 + (lane >> 4), ch = lane & 15;
        const u32x4 v = *(const LAS u32x4*)(stg + row * 128 + ch * 8);
        const u32x4 z = *(const u32x4*)(Zrow0 + (size_t)row * zpitch + ch * 8);
        u32x4 w;
#pragma unroll
        for (int e = 0; e < 4; ++e) { const float a = __uint_as_float(v[e] << 16) * __uint_as_float(z[e] << 16), b = __uint_as_float(v[e] & 0xffff0000u) * __uint_as_float(z[e] & 0xffff0000u); w[e] = cvtpk(a, b); }
        *(u32x4*)(Orow0 + (size_t)row * opitch + ch * 8) = w; }
}

__device__ __forceinline__ void fox_unit(int wv, int b, int h, int qb, const bf16_t* __restrict__ HB, const bf16_t* __restrict__ CNB, bf16_t* __restrict__ OA, LAS char* lds) {
    const int tid = tid_fresh(wv), wid = wv, lane = tid & 63, r32 = lane & 31, hi = lane >> 5;
    const int q0 = qb * 256, qlo = q0 + wid * QBLK, tpos = qlo + r32;
    const bf16_t* Qrow = HB + (size_t)(b * S_ + tpos) * PITCH + H_FQ + h * 128;
    bf16x8 qr[8];
#pragma unroll
    for (int d0 = 0; d0 < 8; ++d0) qr[d0] = *(const bf16x8*)(Qrow + d0 * 16 + hi * 8);
    const bf16_t* Kp = HB + (size_t)(b * S_) * PITCH + H_FK + h * 128;
    const bf16_t* Vp = HB + (size_t)(b * S_) * PITCH + H_FV + h * 128;
    f32x16 o[4]; float l_reg;
    attn_pass<0, PITCH>(wv, Kp, Vp, CNB + (size_t)(b * 8 + h) * S_ * 8, 0, 4 * qb + 4, qr, tpos, qlo, 0u, nullptr, lds, o, l_reg);
    LAS float* ws = (LAS float*)(lds + L_WS) + wid * 64;
    if (hi == 0) ws[r32] = __builtin_amdgcn_rcpf(l_reg);
    __syncthreads();
    store_rows(o, ws, (LAS bf16_t*)(lds + wid * 8192), OA + (size_t)(b * S_ + qlo) * 1024 + h * 128, 1024, HB + (size_t)(b * S_ + qlo) * PITCH + H_FZ + h * 128, PITCH, lane);
}

__device__ __forceinline__ void scale_rows(f32x16* o, LAS float* wsw, float rowscale, int r32, int hi) {
    if (hi == 0) wsw[r32] = rowscale;
    asm volatile("s_waitcnt lgkmcnt(0)" ::: "memory");
#pragma unroll
    for (int r = 0; r < 16; ++r) { const float sc = wsw[crow(r, hi)];
#pragma unroll
        for (int d = 0; d < 4; ++d) o[d][r] *= sc; }
    asm volatile("s_waitcnt lgkmcnt(0)" ::: "memory");
}
__device__ __forceinline__ void scr_store(const f32x16* o, float* scr, int tid) {
#pragma unroll
    for (int d = 0; d < 4; ++d)
#pragma unroll
        for (int q = 0; q < 4; ++q) *(f32x4*)(scr + (size_t)((d * 4 + q) * 512 + tid) * 4) = (f32x4){o[d][4 * q], o[d][4 * q + 1], o[d][4 * q + 2], o[d][4 * q + 3]};
}
__device__ __forceinline__ void scr_add(f32x16* o, const float* scr, int tid) {
#pragma unroll
    for (int d = 0; d < 4; ++d)
#pragma unroll
        for (int q = 0; q < 4; ++q) { const f32x4 v = *(const f32x4*)(scr + (size_t)((d * 4 + q) * 512 + tid) * 4);
#pragma unroll
            for (int e = 0; e < 4; ++e) o[d][4 * q + e] += v[e]; }
}

__device__ __forceinline__ void nsa_unit(int wv, int b, int g, int cur, const bf16_t* __restrict__ HB, const bf16_t* __restrict__ KCMP, const bf16_t* __restrict__ VCMP,
                                         const float* __restrict__ NGATE, float* __restrict__ scr, bf16_t* __restrict__ OB, LAS char* lds) {
    const int tid_ = tid_fresh(wv);
    const int tid = tid_, wid = wv, lane = tid & 63, r32 = lane & 31, hi = lane >> 5;
    const int hp = wid >> 1, head = g * 4 + hp, qrow = (wid & 1) * 32 + r32, qlo = 64 * cur + (wid & 1) * 32, tpos = qlo + r32;
    const size_t trow = (size_t)(b * S_ + tpos);
    LAS float* wsw = (LAS float*)(lds + L_WS) + wid * 64;
    const LAS float* lut = (const LAS float*)(lds + L_LUT) + head * 128;
    bf16x8 qr[8];
    { const bf16_t* Qrow = HB + trow * PITCH + H_NQ + head * 128;
#pragma unroll
      for (int d0 = 0; d0 < 8; ++d0) qr[d0] = *(const bf16x8*)(Qrow + d0 * 16 + hi * 8); }
    f32x16 o[4];
    unsigned selbits;
    {
        LAS char* V_lds = lds + L_V; LAS char* K_lds = lds + L_K;
        const bool two = 64 * cur + 63 >= 1055;
        const int sr = tid >> 4, sc = (tid & 15) * 8;
        const bf16_t* Kc = KCMP + (size_t)(b * 2 + g) * 128 * 128; const bf16_t* Vc = VCMP + (size_t)(b * 2 + g) * 128 * 128;
        bf16x8 k0 = *(const bf16x8*)(Kc + (size_t)sr * 128 + sc), k1 = *(const bf16x8*)(Kc + (size_t)(32 + sr) * 128 + sc);
        bf16x8 v0 = *(const bf16x8*)(Vc + (size_t)sr * 128 + sc), v1 = *(const bf16x8*)(Vc + (size_t)(32 + sr) * 128 + sc);
        bf16x8 k2 = k0, k3 = k1, v2 = v0, v3 = v1;
        if (two) { k2 = *(const bf16x8*)(Kc + (size_t)(64 + sr) * 128 + sc); k3 = *(const bf16x8*)(Kc + (size_t)(96 + sr) * 128 + sc);
                   v2 = *(const bf16x8*)(Vc + (size_t)(64 + sr) * 128 + sc); v3 = *(const bf16x8*)(Vc + (size_t)(96 + sr) * 128 + sc); }
        __syncthreads();
        { const int vst0 = v_st(sr, sc), vst1 = v_st(32 + sr, sc), kws = KSWZ(sr, sc * 2);
          *(LAS bf16x8*)(V_lds + vst0) = v0; *(LAS bf16x8*)(V_lds + vst1) = v1; *(LAS bf16x8*)(K_lds + kws) = k0; *(LAS bf16x8*)(K_lds + kws + 32 * 256) = k1;
          if (two) { *(LAS bf16x8*)(V_lds + SHM_V + vst0) = v2; *(LAS bf16x8*)(V_lds + SHM_V + vst1) = v3; *(LAS bf16x8*)(K_lds + SHM_K + kws) = k2; *(LAS bf16x8*)(K_lds + SHM_K + kws + 32 * 256) = k3; } }
        __syncthreads();
        f32x16 pA0, pA1, pB0, pB1;
        init_lut_cmp(pA0, pA1, lut, tpos - 31 - 64 * hi + 1);
        qkt<0, false>(pA0, pA1, K_lds, nullptr, r32, hi, qr, true);
        if (two) { init_lut_cmp(pB0, pB1, lut, tpos - 31 - 16 * 64 - 64 * hi + 1); qkt<1, false>(pB0, pB1, K_lds, nullptr, r32, hi, qr, true); }
        else init_const(pB0, pB1, NEGINF);
        float mx = -1e30f;
#pragma unroll
        for (int r = 0; r < 16; ++r) mx = fmaxf(fmaxf(mx, pA0[r]), fmaxf(pA1[r], fmaxf(pB0[r], pB1[r])));
        { auto rr = __builtin_amdgcn_permlane32_swap(__float_as_uint(mx), __float_as_uint(mx), false, false); mx = fmaxf(__uint_as_float(rr[0]), __uint_as_float(rr[1])); }
        constexpr float C2 = 1.4426950408889634f * SCALE;
        const float mL = -mx * C2; float ps = 0.f;
#pragma unroll
        for (int r = 0; r < 16; ++r) { pA0[r] = __builtin_amdgcn_exp2f(fmaf(pA0[r], C2, mL)); pA1[r] = __builtin_amdgcn_exp2f(fmaf(pA1[r], C2, mL));
                                       pB0[r] = __builtin_amdgcn_exp2f(fmaf(pB0[r], C2, mL)); pB1[r] = __builtin_amdgcn_exp2f(fmaf(pB1[r], C2, mL));
                                       ps += (pA0[r] + pA1[r]) + (pB0[r] + pB1[r]); }
        { auto rr = __builtin_amdgcn_permlane32_swap(__float_as_uint(ps), __float_as_uint(ps), false, false); ps = __uint_as_float(rr[0]) + __uint_as_float(rr[1]); }
        const float inv = ps > 0.f ? 1.f / ps : 0.f;
#pragma unroll
        for (int r = 0; r < 16; ++r) { pA0[r] *= inv; pA1[r] *= inv; pB0[r] *= inv; pB1[r] *= inv; }
        if (cur >= 8) {
            LAS float* imph = (LAS float*)(lds + L_IMPH) + (hp * 64 + qrow) * 33;
            float up_prev = 0.f;
#define IMP_SLOTS(X, S0) do { _Pragma("unroll") for (int q = 0; q < 4; ++q) {                                                          \
                const float qs_ = (X[4 * q] + X[4 * q + 1]) + (X[4 * q + 2] + X[4 * q + 3]); const float le_ = X[4 * q + 3];            \
                auto rr = __builtin_amdgcn_permlane32_swap(__float_as_uint(le_), __float_as_uint(le_), false, false);                   \
                const float lo_ = __uint_as_float(rr[0]), up_ = __uint_as_float(rr[1]);                                               \
                imph[2 * ((S0) + q) + hi] = qs_ + (hi ? lo_ : up_prev); up_prev = up_; } } while (0)
            IMP_SLOTS(pA0, 0); IMP_SLOTS(pA1, 4); IMP_SLOTS(pB0, 8); IMP_SLOTS(pB1, 12);
#undef IMP_SLOTS
        }
        bf16x8 pa0, pa1, pa2, pa3;
#pragma unroll
        for (int d = 0; d < 4; ++d) o[d] = f32x16{};
        const int vb0 = (int)(size_t)V_lds + v_rd_base(lane);
        PK4(pA0, 0, pa0); PK4(pA0, 8, pa1); PK4(pA1, 0, pa2); PK4(pA1, 8, pa3);
        pv_tile<0>(o, vb0, pa0, pa1, pa2, pa3, true);
        if (two) { PK4(pB0, 0, pa0); PK4(pB0, 8, pa1); PK4(pB1, 0, pa2); PK4(pB1, 8, pa3); pv_tile<1>(o, vb0, pa0, pa1, pa2, pa3, true); }
        scale_rows(o, wsw, NGATE[trow * 24 + head * 3 + 0], r32, hi);
        scr_store(o, scr, tid);
        if (cur >= 8) {
            __syncthreads();
            LAS float* IH = (LAS float*)(lds + L_IMPH); LAS float* I2 = (LAS float*)(lds + L_IMP2);
            for (int i = tid; i < 2048; i += 512) { const int q = i >> 5, j = i & 31;
                I2[q * 33 + j] = ((IH[(0 * 64 + q) * 33 + j] + IH[(1 * 64 + q) * 33 + j]) + IH[(2 * 64 + q) * 33 + j]) + IH[(3 * 64 + q) * 33 + j]; }
            __syncthreads();
            if (wid == 0) {
                unsigned chosen = 1u | (1u << cur) | (1u << (cur - 1));
                for (int k = 0; k < 5; ++k) { float bv = -1.f; int bj = 0;
                    for (int j = 1; j <= cur - 2; ++j) { const float v = I2[lane * 33 + j]; if (!((chosen >> j) & 1u) && v > bv) { bv = v; bj = j; } }
                    chosen |= 1u << bj; }
                ((LAS unsigned*)(lds + L_SELM))[lane] = chosen;
            }
            __syncthreads();
            selbits = ((const LAS unsigned*)(lds + L_SELM))[qrow];
        } else selbits = (1u << (cur + 1)) - 1u;
    }
    float l_reg;
    attn_pass<2, PITCH>(wv, HB + (size_t)(b * S_) * PITCH + H_KS + g * 128, HB + (size_t)(b * S_) * PITCH + H_VS + g * 128, nullptr, 0, cur + 1, qr, tpos, qlo, selbits, lut, lds, o, l_reg);
    scale_rows(o, wsw, NGATE[(size_t)(b * S_ + tpos) * 24 + head * 3 + 1] * __builtin_amdgcn_rcpf(l_reg), r32, hi);
    scr_add(o, scr, tid);
    scr_store(o, scr, tid);
    { const int jl = cur >= 8 ? cur - 8 : 0;
      attn_pass<3, PITCH>(wv, HB + (size_t)(b * S_) * PITCH + H_KW + g * 128, HB + (size_t)(b * S_) * PITCH + H_VW + g * 128, nullptr, jl, cur + 1 - jl, qr, tpos, qlo, 0u, lut, lds, o, l_reg); }
    scale_rows(o, wsw, NGATE[(size_t)(b * S_ + tpos) * 24 + head * 3 + 2] * __builtin_amdgcn_rcpf(l_reg), r32, hi);
    scr_add(o, scr, tid);
    if (hi == 0) wsw[r32] = 1.f;
    __syncthreads();
    store_rows(o, wsw, (LAS bf16_t*)(lds + wid * 8192), OB + (size_t)(b * S_ + qlo) * 1024 + head * 128, 1024, HB + (size_t)(b * S_ + qlo) * PITCH + H_NZ + head * 128, PITCH, lane);
}
__device__ __forceinline__ void build_lut(int wv, const float* __restrict__ rel_bias, LAS char* lds) {
    LAS float* L = (LAS float*)(lds + L_LUT);
    for (int i = tid_fresh(wv); i < 1024; i += NTHREADS) { const int h = i >> 7, k = i & 127;
        L[i] = k == 0 ? NEGINF : (k <= 113 ? (rel_bias[rel_bucket(k - 1) * 8 + h] - rel_bias[31 * 8 + h]) * 11.313708498984761f : 0.f); }
    __syncthreads();
}

__device__ const unsigned short UNIT_ORDER[512] = {31,63,95,127,159,191,223,255,30,62,94,126,158,190,222,254,29,61,93,125,157,189,221,253,28,60,92,124,156,188,220,252,27,59,91,123,155,187,219,251,26,58,90,122,154,186,218,250,25,57,89,121,153,185,217,249,24,56,88,120,152,184,216,248,23,55,87,119,151,183,215,247,22,54,86,118,150,182,214,246,21,53,85,117,149,181,213,245,20,52,84,116,148,180,212,244,32775,32783,32791,32799,32807,32815,32823,32831,19,51,32839,32847,32855,32863,32871,32879,32887,32895,83,115,32903,32911,32919,32927,32935,32943,32951,32959,147,179,32967,32975,32983,32991,32999,33007,33015,33023,211,243,18,50,82,114,146,178,210,242,17,49,81,113,145,177,209,241,16,48,80,112,144,176,208,240,32774,32782,32790,32798,32806,32814,32822,32830,15,47,32838,32846,32854,32862,32870,32878,32886,32894,79,111,32902,32910,32918,32926,32934,32942,32950,32958,143,175,32966,32974,32982,32990,32998,33006,33014,33022,207,239,14,46,78,110,142,174,206,238,13,45,77,109,141,173,205,237,12,44,76,108,140,172,204,236,32773,32781,32789,32797,32805,32813,32821,32829,11,43,32837,32845,32853,32861,32869,32877,32885,32893,75,107,32901,32909,32917,32925,32933,32941,32949,32957,139,171,32965,32973,32981,32989,32997,33005,33013,33021,203,235,10,42,74,106,138,170,202,234,9,41,73,105,137,169,201,233,8,40,72,104,136,168,200,232,32772,32780,32788,32796,32804,32812,32820,32828,32836,32844,32852,32860,32868,32876,32884,32892,32900,32908,32916,32924,32932,32940,32948,32956,32964,32972,32980,32988,32996,33004,33012,33020,7,39,71,103,135,167,199,231,6,38,70,102,134,166,198,230,32771,32779,32787,32795,32803,32811,32819,32827,32835,32843,32851,32859,32867,32875,32883,32891,32899,32907,32915,32923,32931,32939,32947,32955,32963,32971,32979,32987,32995,33003,33011,33019,5,37,69,101,133,165,197,229,4,36,68,100,132,164,196,228,32770,32778,32786,32794,32802,32810,32818,32826,32834,32842,32850,32858,32866,32874,32882,32890,32898,32906,32914,32922,32930,32938,32946,32954,32962,32970,32978,32986,32994,33002,33010,33018,3,35,67,99,131,163,195,227,2,34,66,98,130,162,194,226,32769,32777,32785,32793,32801,32809,32817,32825,32833,32841,32849,32857,32865,32873,32881,32889,32897,32905,32913,32921,32929,32937,32945,32953,32961,32969,32977,32985,32993,33001,33009,33017,1,33,65,97,129,161,193,225,0,32,64,96,128,160,192,224,32768,32776,32784,32792,32800,32808,32816,32824,32832,32840,32848,32856,32864,32872,32880,32888,32896,32904,32912,32920,32928,32936,32944,32952,32960,32968,32976,32984,32992,33000,33008,33016};
__device__ __forceinline__ void attn_phase(int wv, const bf16_t* __restrict__ HB, const bf16_t* __restrict__ CNB, const bf16_t* __restrict__ KCMP, const bf16_t* __restrict__ VCMP,
                                           const float* __restrict__ NGATE, const float* __restrict__ rel_bias, float* __restrict__ scr, bf16_t* __restrict__ OA, bf16_t* __restrict__ OB,
                                           unsigned* __restrict__ qctr, LAS char* lds) {
    build_lut(wv, rel_bias, lds);
    volatile LAS unsigned* qw = (volatile LAS unsigned*)(lds + L_QW);
    for (;;) {
        if (tid_fresh(wv) == 0) qw[0] = atomicAdd(qctr, 1u);
        __syncthreads();
        const unsigned i = qw[0];
        __syncthreads();
        if (i >= 512u) break;
        const unsigned u = UNIT_ORDER[i];
        if (u & 0x8000u) fox_unit(wv, (int)((u >> 6) & 3u), (int)((u >> 3) & 7u), (int)(u & 7u), HB, CNB, OA, lds);
        else nsa_unit(wv, (int)((u >> 6) & 3u), (int)((u >> 5) & 1u), (int)(u & 31u), HB, KCMP, VCMP, NGATE, scr, OB, lds);
    }
}
#undef KSWZ
#undef SBAR
#undef PK4
#undef VMW
#undef LAS
}

#define RLX_AGENT __ATOMIC_RELAXED, __HIP_MEMORY_SCOPE_AGENT
#define XB_TMO      128
#define XB_XCNT(j)  (256  + 64 * (j))
#define XB_XSUB(j)  (1280 + 64 * (j))
#define XB_XGEN(j)  (2304 + 64 * (j))
#define XB_TOP      3328
#define XB_TOPGEN   3392
#define XCD_BAR_WORDS 3456
#define XB_SPIN_CAP (1u << 18)

__device__ __forceinline__ unsigned xb_ld(unsigned* p)              { return __hip_atomic_load(p, __ATOMIC_RELAXED, __HIP_MEMORY_SCOPE_AGENT); }
__device__ __forceinline__ unsigned xb_add(unsigned* p, unsigned v) { return __hip_atomic_fetch_add(p, v, __ATOMIC_RELAXED, __HIP_MEMORY_SCOPE_AGENT); }
__device__ __forceinline__ unsigned xb_xcc_id() { return (unsigned)__builtin_amdgcn_s_getreg((3 << 11) | 20) & 0xFu; }
#define XB_SPIN(cond, bar) do { unsigned _sp = 0; while (cond) { __builtin_amdgcn_s_sleep(1); \
    if ((++_sp & 255u) == 0u) { if (xb_ld(&(bar)[XB_TMO])) break; if (_sp > XB_SPIN_CAP) { atomicAdd(&(bar)[XB_TMO], 1u); break; } } } } while (0)

struct XcdBarrier {
    unsigned* bar; unsigned x;
    volatile __attribute__((address_space(3))) unsigned* st;
};

__device__ __forceinline__ XcdBarrier xcd_barrier_post(unsigned* bar, volatile __attribute__((address_space(3))) unsigned* st) {
    XcdBarrier b; b.bar = bar; b.x = xb_xcc_id(); b.st = st;
    if (threadIdx.x == 0) (void)xb_add(&bar[XB_XCNT(b.x)], 1u);
    return b;
}
__device__ __forceinline__ void xcd_barrier_complete(unsigned* bar, unsigned x, unsigned& nloc, unsigned& nx) {
    const unsigned G = gridDim.x * gridDim.y * gridDim.z;
    unsigned sum, cnt, mine, sp = 0u;
    for (;;) {
        sum = 0u; cnt = 0u; mine = 0u;
#pragma unroll
        for (unsigned j = 0; j < 16; ++j) { const unsigned c = xb_ld(&bar[XB_XCNT(j)]); sum += c; cnt += (c > 0u) ? 1u : 0u; mine = (j == x) ? c : mine; }
        if (sum == G) break;
        __builtin_amdgcn_s_sleep(1);
        if ((++sp & 255u) == 0u) { if (xb_ld(&bar[XB_TMO])) break; if (sp > XB_SPIN_CAP) { atomicAdd(&bar[XB_TMO], 1u); break; } }
    }
    nloc = mine > 0u ? mine : 1u; nx = cnt > 0u ? cnt : 1u;
}

__device__ __forceinline__ void xcd_barrier(const XcdBarrier& b) {
    asm volatile("s_waitcnt vmcnt(0)" ::: "memory");
    __syncthreads();
    if (threadIdx.x == 0) {
        unsigned* bar = b.bar;
        __builtin_amdgcn_s_waitcnt(0);
        unsigned nloc = b.st[0], nx = b.st[1];
        if (nloc == 0u) { xcd_barrier_complete(bar, b.x, nloc, nx); b.st[0] = nloc; b.st[1] = nx; }
        const unsigned old = xb_add(&bar[XB_XSUB(b.x)], 1u);
        const unsigned gen = old / nloc;
        if (old + 1u == (gen + 1u) * nloc) {
            __builtin_amdgcn_fence(__ATOMIC_RELEASE, "agent");
            asm volatile("s_waitcnt vmcnt(0)" ::: "memory");
            const unsigned og = xb_add(&bar[XB_TOP], 1u);
            const unsigned tg = og / nx;
            if (og + 1u == (tg + 1u) * nx) xb_add(&bar[XB_TOPGEN], 1u);
            else XB_SPIN(xb_ld(&bar[XB_TOPGEN]) == tg, bar);
            __builtin_amdgcn_fence(__ATOMIC_ACQUIRE, "agent");
            xb_add(&bar[XB_XGEN(b.x)], 1u);
            asm volatile("s_waitcnt vmcnt(0)" ::: "memory");
        } else {
            XB_SPIN(xb_ld(&bar[XB_XGEN(b.x)]) == gen, bar);
            __builtin_amdgcn_fence(__ATOMIC_ACQUIRE, "agent");
            asm volatile("s_waitcnt vmcnt(0)" ::: "memory");
        }
    }
    __syncthreads();
}


__global__ void __launch_bounds__(NTHREADS, 2) fwd_megakernel(const float* i0, const float* i1, const float* i2, const float* i3, const float* i4, const float* i5, const float* i6, const float* i7,
                                                               const float* i8, const float* i9, const float* i10, const float* i11, const float* i12, const float* i13, const float* i14,
                                                               float* out_, unsigned char* ws_) {
    Params p; p.in[0] = i0; p.in[1] = i1; p.in[2] = i2; p.in[3] = i3; p.in[4] = i4; p.in[5] = i5; p.in[6] = i6; p.in[7] = i7; p.in[8] = i8; p.in[9] = i9; p.in[10] = i10; p.in[11] = i11;
    p.in[12] = i12; p.in[13] = i13; p.in[14] = i14; p.out = out_; p.ws = ws_;
    extern __shared__ __attribute__((aligned(16))) unsigned char lds[];
    const int wv = __builtin_amdgcn_readfirstlane(threadIdx.x >> 6);
    PG8_LAS unsigned char* ldsl = (PG8_LAS unsigned char*)lds;
    volatile PG8_LAS unsigned* bst = (volatile PG8_LAS unsigned*)(ldsl + 131072 + 512);
    if (wv == 0) { bst[0] = 0u; bst[1] = 0u; }
    __syncthreads();
    XcdBarrier bar = xcd_barrier_post((unsigned*)(p.ws + WS_CTL) + 4096, bst);
#define WSP(name) size_t name##_z = 0; asm volatile("" : "+s"(name##_z)); unsigned char* name = p.ws + name##_z
    { WSP(ws); p0_phase(wv, p, (bf16_t*)(ws + WS_XB), (bf16_t*)(ws + WS_WINT), (bf16_t*)(ws + WS_WABT), (bf16_t*)(ws + WS_WOT), (bf16_t*)(ws + WS_W1T), (bf16_t*)(ws + WS_W2T), (float*)(ws + WS_POSW), lds); }
    xcd_barrier(bar);
    { WSP(ws); pg8::Gemm g{(bf16_t*)(ws + WS_XB), (bf16_t*)(ws + WS_WINT), M_, 12032, 2048}; pg8::StaticOrder S; S.init(M_, 12032, (int)gridDim.x, (int)blockIdx.x);
      pg8::EpiH1 E{(bf16_t*)(ws + WS_HB), (float*)(ws + WS_LOGF), (float*)(ws + WS_NGATE), p.in[2]};
      pg8::gemm_phase<pg8::EpiH1, pg8::StaticOrder, true, true>(wv, ldsl, g, S, E); }
    xcd_barrier(bar);
    { WSP(ws); compress_hidden_phase(wv, (bf16_t*)(ws + WS_HB), (bf16_t*)(ws + WS_W1T), (float*)(ws + WS_POSW), (bf16_t*)(ws + WS_HID), lds);
      cumsum_phase(wv, (float*)(ws + WS_LOGF), (bf16_t*)(ws + WS_CN)); }
    xcd_barrier(bar);
    { WSP(ws); compress_out_phase(wv, (bf16_t*)(ws + WS_HID), (bf16_t*)(ws + WS_W2T), (bf16_t*)(ws + WS_KCMP), (bf16_t*)(ws + WS_VCMP)); }
    xcd_barrier(bar);
    { WSP(ws); att::attn_phase(wv, (bf16_t*)(ws + WS_HB), (bf16_t*)(ws + WS_CN), (bf16_t*)(ws + WS_KCMP), (bf16_t*)(ws + WS_VCMP), (float*)(ws + WS_NGATE), p.in[14],
                      (float*)(ws + WS_T1B) + (size_t)blockIdx.x * 32768, (bf16_t*)(ws + WS_OA), (bf16_t*)(ws + WS_OB), (unsigned*)(ws + WS_CTL) + 64, (PG8_LAS char*)lds); }
    xcd_barrier(bar);
    { WSP(ws); pg8::Gemm g{(bf16_t*)(ws + WS_OA), (bf16_t*)(ws + WS_WABT), 2 * M_, 4096, 1024}; pg8::PairOrder S{(int)gridDim.x, (int)blockIdx.x};
      pg8::EpiMerge E{(bf16_t*)(ws + WS_HB), (pg8::u32x4*)(ws + WS_T1B), (bf16_t*)(ws + WS_MRG)};
      pg8::gemm_phase<pg8::EpiMerge, pg8::PairOrder, true, true>(wv, ldsl, g, S, E); }
    xcd_barrier(bar);
    { WSP(ws); pg8::Gemm g{(bf16_t*)(ws + WS_MRG), (bf16_t*)(ws + WS_WOT), M_, 2048, 2048}; pg8::StaticOrder S; S.init(M_, 2048, (int)gridDim.x, (int)blockIdx.x);
      pg8::EpiRes5 E{p.in[0], p.out};
      pg8::gemm_phase<pg8::EpiRes5, pg8::StaticOrder, true, true>(wv, ldsl, g, S, E); }
    xcd_barrier(bar);
    ln_phase(wv, p.out, p.in[12], p.in[13], lds);
#undef WSP
}
}

extern "C" void kernel_launch(void* const* d_in, const int* in_sizes, int n_in, void* d_out, int out_size, void* d_ws, size_t ws_size, hipStream_t stream) {
    static int grid_blocks = 0;
    if (grid_blocks == 0) {
        if (n_in != 15 || ws_size < WS_END || out_size != M_ * D_) { fprintf(stderr, "kernel_launch: unexpected shapes/ws (%d inputs, ws %zu, out %d)\n", n_in, ws_size, out_size); grid_blocks = -1; return; }
        int dev = 0, cus = 0, per_cu = 0;
        (void)hipGetDevice(&dev);
        (void)hipDeviceGetAttribute(&cus, hipDeviceAttributeMultiprocessorCount, dev);
        if (hipFuncSetAttribute((const void*)fwd_megakernel, hipFuncAttributeMaxDynamicSharedMemorySize, LDS_BYTES) != hipSuccess) { fprintf(stderr, "kernel_launch: hipFuncSetAttribute failed\n"); grid_blocks = -1; return; }
        (void)hipOccupancyMaxActiveBlocksPerMultiprocessor(&per_cu, (const void*)fwd_megakernel, NTHREADS, LDS_BYTES);
        if (per_cu < 1) { fprintf(stderr, "kernel_launch: occupancy query says %d blocks/CU\n", per_cu); grid_blocks = -1; return; }
        grid_blocks = cus;
        fprintf(stderr, "kernel_launch: %d CUs, occupancy %d/CU, grid %d, ws %zu\n", cus, per_cu, grid_blocks, ws_size);
    }
    if (grid_blocks < 0) return;
    (void)hipMemsetAsync((char*)d_ws + WS_CTL, 0, 65536, stream);
    void* ptrs[17];
    for (int i = 0; i < 15; ++i) ptrs[i] = d_in[i];
    ptrs[15] = d_out; ptrs[16] = d_ws;
    void* args[17];
    for (int i = 0; i < 17; ++i) args[i] = &ptrs[i];
    hipError_t e = hipLaunchCooperativeKernel((const void*)fwd_megakernel, dim3(grid_blocks), dim3(NTHREADS), args, LDS_BYTES, stream);
    if (e != hipSuccess) fprintf(stderr, "cooperative launch failed: %s (grid %d)\n", hipGetErrorString(e), grid_blocks);
}
```
